# Optimizing an MI355X kernel written in HIP

```python
import math
import jax, jax.numpy as jnp
from jax import lax
import numpy as np

D_MODEL = 1024
BATCH = 8
SEQ = 2048
DEPTH = 1

NSA_HEADS = 8
NSA_KV_GROUPS = 2
NSA_REP = NSA_HEADS // NSA_KV_GROUPS
NSA_HEAD_DIM = 64
CMP_LEN = 32
CMP_STRIDE = 16
SLC_LEN = 64
SLC_TOPK = 8
WIN_LEN = 512
Q_BLK = 128
SEL_Q_BLK = 64
FORCE_SCORE = 1.0e4
NEG = -1.0e30
GDN_HEADS = 4
GDN_HEAD_DIM = 128
GDN_CONV = 4
GDN_CHUNK = 64
FFN_DIM = 2816
FFN_CONV = 3
DEEPNORM_ALPHA = (2.0 * DEPTH) ** 0.25
DEEPNORM_BETA = (8.0 * DEPTH) ** -0.25
LN_EPS = 1e-5
RMS_EPS = 1e-6

NSA_Q_W = NSA_HEADS * NSA_HEAD_DIM
NSA_KV_W = NSA_KV_GROUPS * NSA_HEAD_DIM
GDN_W = GDN_HEADS * GDN_HEAD_DIM
IN_WIDTHS = (NSA_Q_W, NSA_KV_W, NSA_KV_W, NSA_KV_W, NSA_KV_W, NSA_KV_W, NSA_KV_W,
             3 * NSA_HEADS, 3 * GDN_W, GDN_HEADS, GDN_HEADS, GDN_W, 2 * D_MODEL)
IN_WIDTH = sum(IN_WIDTHS)

kernel_name = "nsa_gdn_gated_hybrid_deepnorm"


def _split_in(h):
    offs = np.cumsum((0,) + IN_WIDTHS)
    return [h[..., int(offs[i]):int(offs[i + 1])] for i in range(len(IN_WIDTHS))]


def layer_norm(x, g, b):
    xf = x.astype(jnp.float32)
    mu = jnp.mean(xf, -1, keepdims=True)
    var = jnp.mean(jnp.square(xf - mu), -1, keepdims=True)
    return ((xf - mu) * lax.rsqrt(var + LN_EPS) * g + b).astype(x.dtype)


def rms_norm(x, w):
    xf = x.astype(jnp.float32)
    return xf * lax.rsqrt(jnp.mean(jnp.square(xf), -1, keepdims=True) + RMS_EPS) * w


def l2_norm(x):
    return x * lax.rsqrt(jnp.sum(jnp.square(x), -1, keepdims=True) + RMS_EPS)


def causal_dwconv(x, w):
    K, S = w.shape[0], x.shape[1]
    xp = jnp.pad(x, ((0, 0), (K - 1, 0), (0, 0)))
    out = xp[:, 0:S] * w[0]
    for j in range(1, K):
        out = out + xp[:, j:j + S] * w[j]
    return out


def alibi_slopes(n):
    return jnp.asarray([2.0 ** (-8.0 * (h + 1) / n) for h in range(n)], jnp.float32)


def nsa_attention(q, kc, vc, ks, vs, kw, vw, gates, cmp_pos, cmp_w1, cmp_w2):
    B, S, _ = q.shape
    G, R, DH = NSA_KV_GROUPS, NSA_REP, NSA_HEAD_DIM
    dt = q.dtype
    f32 = jnp.float32
    scale = DH ** -0.5
    q = q.reshape(B, S, G, R, DH).transpose(0, 2, 3, 1, 4)
    heads = lambda t: t.reshape(B, S, G, DH).transpose(0, 2, 1, 3)
    kc, vc, ks, vs, kw, vw = (heads(t) for t in (kc, vc, ks, vs, kw, vw))
    slopes = alibi_slopes(NSA_HEADS).reshape(G, R)
    t_pos = jnp.arange(S)

    n_cmp = (S - CMP_LEN) // CMP_STRIDE + 1
    cmp_idx = np.arange(n_cmp)[:, None] * CMP_STRIDE + np.arange(CMP_LEN)[None, :]

    def compress(t, i):
        blk = t[:, :, cmp_idx] + cmp_pos[i]
        blk = blk.reshape(B, G, n_cmp, CMP_LEN * DH)
        return jax.nn.gelu(blk @ cmp_w1[i]) @ cmp_w2[i]

    k_cmp, v_cmp = compress(kc, 0), compress(vc, 1)
    cmp_end = jnp.asarray(cmp_idx[:, -1])
    dist_c = (t_pos[:, None] - cmp_end[None, :]).astype(f32)
    valid_c = dist_c >= 0
    s_c = jnp.einsum('bgrtd,bgnd->bgrtn', q, k_cmp).astype(f32) * scale
    s_c = jnp.where(valid_c, s_c - slopes[None, :, :, None, None] * dist_c, NEG)
    p_cmp = jax.nn.softmax(s_c, axis=-1) * valid_c
    o_cmp = jnp.einsum('bgrtn,bgnd->bgrtd', p_cmp.astype(dt), v_cmp)

    n_slc = S // SLC_LEN
    c_start = np.arange(n_cmp)[:, None] * CMP_STRIDE
    s_start = np.arange(n_slc)[None, :] * SLC_LEN
    overlap = ((c_start < s_start + SLC_LEN) & (c_start + CMP_LEN > s_start)).astype(np.float32)
    score = jnp.einsum('bgrtn,nj->bgtj', p_cmp, jnp.asarray(overlap))
    blk = jnp.arange(n_slc)[None, :]
    cur = (t_pos // SLC_LEN)[:, None]
    forced = (blk == 0) | (blk == cur) | (blk == cur - 1)
    score = jnp.where(forced, FORCE_SCORE, jnp.where(blk <= cur, score, -1.0))
    k_sel = min(SLC_TOPK, n_slc)
    _, idx = lax.top_k(score, k_sel)

    ks_blk = ks.reshape(B, G, n_slc, SLC_LEN, DH)
    vs_blk = vs.reshape(B, G, n_slc, SLC_LEN, DH)
    nq = S // SEL_Q_BLK
    q_ch = jnp.moveaxis(q.reshape(B, G, R, nq, SEL_Q_BLK, DH), 3, 0)
    i_ch = jnp.moveaxis(idx.reshape(B, G, nq, SEL_Q_BLK, k_sel), 2, 0)
    t_ch = t_pos.reshape(nq, SEL_Q_BLK)
    bi = jnp.arange(B)[:, None, None, None]
    gi = jnp.arange(G)[None, :, None, None]
    offs = jnp.arange(SLC_LEN)
    n_key = k_sel * SLC_LEN

    def sel_chunk(args):
        qc, ic, tc = args
        kg = ks_blk[bi, gi, ic].reshape(B, G, SEL_Q_BLK, n_key, DH)
        vg = vs_blk[bi, gi, ic].reshape(B, G, SEL_Q_BLK, n_key, DH)
        kpos = (ic[..., None] * SLC_LEN + offs).reshape(B, G, SEL_Q_BLK, n_key)
        dist = (tc[:, None] - kpos).astype(f32)
        s = jnp.einsum('bgrtd,bgtsd->bgrts', qc, kg).astype(f32) * scale
        s = jnp.where((dist >= 0)[:, :, None],
                      s - slopes[None, :, :, None, None] * dist[:, :, None], NEG)
        p = jax.nn.softmax(s, axis=-1)
        return jnp.einsum('bgrts,bgtsd->bgrtd', p.astype(dt), vg)

    o_slc = lax.map(sel_chunk, (q_ch, i_ch, t_ch))
    o_slc = jnp.moveaxis(o_slc, 0, 3).reshape(B, G, R, S, DH)

    nb = S // Q_BLK
    nw = WIN_LEN // Q_BLK

    def band(t):
        tb = jnp.pad(t.reshape(B, G, nb, Q_BLK, DH), ((0, 0), (0, 0), (nw, 0), (0, 0), (0, 0)))
        return jnp.concatenate([tb[:, :, j:j + nb] for j in range(nw + 1)], axis=3)

    kwb, vwb = band(kw), band(vw)
    kpos_w = (jnp.arange(nb)[:, None] - nw) * Q_BLK + jnp.arange((nw + 1) * Q_BLK)[None, :]
    tq = jnp.arange(nb)[:, None] * Q_BLK + jnp.arange(Q_BLK)[None, :]
    dist_w = tq[:, :, None] - kpos_w[:, None, :]
    valid_w = (dist_w >= 0) & (dist_w < WIN_LEN) & (kpos_w[:, None, :] >= 0)
    qb = q.reshape(B, G, R, nb, Q_BLK, DH)
    s_w = jnp.einsum('bgrcqd,bgckd->bgrcqk', qb, kwb).astype(f32) * scale
    s_w = jnp.where(valid_w, s_w - slopes[None, :, :, None, None, None] * dist_w.astype(f32), NEG)
    p_w = jax.nn.softmax(s_w, axis=-1)
    o_win = jnp.einsum('bgrcqk,bgckd->bgrcqd', p_w.astype(dt), vwb).reshape(B, G, R, S, DH)

    g = jax.nn.sigmoid(gates).reshape(B, S, 3, G, R).transpose(2, 0, 3, 4, 1)[..., None]
    o = g[0] * o_cmp + g[1] * o_slc + g[2] * o_win
    return o.transpose(0, 3, 1, 2, 4).reshape(B, S, NSA_Q_W)


def gated_deltanet(qkv, beta_raw, decay_raw, gate_raw, conv_w, a_log, dt_bias, norm_w):
    B, S, _ = qkv.shape
    H, Dh, C = GDN_HEADS, GDN_HEAD_DIM, GDN_CHUNK
    dt = qkv.dtype
    f32 = jnp.float32
    qkv = jax.nn.silu(causal_dwconv(qkv, conv_w)).astype(f32)
    q, k, v = jnp.split(qkv, 3, axis=-1)
    heads = lambda t: t.reshape(B, S, H, Dh).transpose(0, 2, 1, 3)
    q = l2_norm(heads(q)) * (Dh ** -0.5)
    k = l2_norm(heads(k))
    v = heads(v)
    beta = jax.nn.sigmoid(beta_raw.astype(f32)).transpose(0, 2, 1)
    g = (-jnp.exp(a_log.astype(f32))[None, :, None]
         * jax.nn.softplus(decay_raw.astype(f32) + dt_bias.astype(f32)).transpose(0, 2, 1))
    N = S // C
    q, k, v = (t.reshape(B, H, N, C, Dh) for t in (q, k, v))
    beta, g = beta.reshape(B, H, N, C), g.reshape(B, H, N, C)
    gcum = jnp.cumsum(g, axis=-1)
    causal = jnp.tril(jnp.ones((C, C), bool))
    strict = jnp.tril(jnp.ones((C, C), bool), -1)
    decay = jnp.exp(jnp.where(causal, gcum[..., :, None] - gcum[..., None, :], -jnp.inf))
    kb = k * beta[..., None]
    m = jnp.where(strict, jnp.einsum('bhncd,bhnsd->bhncs', kb, k) * decay, 0.0)
    eye = jnp.eye(C, dtype=f32)
    T = lax.linalg.triangular_solve(eye + m, jnp.broadcast_to(eye, m.shape),
                                    left_side=True, lower=True, unit_diagonal=True)
    u = T @ (v * beta[..., None])
    w = T @ (kb * jnp.exp(gcum)[..., None])
    a_qk = jnp.einsum('bhncd,bhnsd->bhncs', q, k) * decay

    def step(state, xs):
        qn, kn, un, wn, an, gn = xs
        v_new = un - wn @ state
        o = (qn * jnp.exp(gn)[..., None]) @ state + an @ v_new
        g_last = gn[..., -1:]
        state = (state * jnp.exp(g_last)[..., None]
                 + jnp.einsum('bhcd,bhce->bhde', kn * jnp.exp(g_last - gn)[..., None], v_new))
        return state, o

    xs = tuple(jnp.moveaxis(t, 2, 0) for t in (q, k, u, w, a_qk, gcum))
    _, o = lax.scan(step, jnp.zeros((B, H, Dh, Dh), f32), xs)
    o = jnp.moveaxis(o, 0, 2).reshape(B, H, S, Dh).transpose(0, 2, 1, 3)
    o = rms_norm(o, norm_w) * jax.nn.silu(gate_raw.astype(f32).reshape(B, S, H, Dh))
    return o.reshape(B, S, GDN_W).astype(dt)


def conv_ffn(x, w_up, conv_w, w_down):
    h = causal_dwconv(x @ w_up, conv_w)
    gate, val = jnp.split(h, 2, axis=-1)
    return (jax.nn.silu(gate) * val) @ w_down


def setup_inputs(seed: int = 0) -> dict:
    key = jax.random.key(seed)
    ks = jax.random.split(key, 24)
    f32 = jnp.float32
    nrm = lambda k, shape, fan_in, gain=1.0: jax.random.normal(k, shape, f32) * (gain * fan_in ** -0.5)
    offs = np.cumsum((0,) + IN_WIDTHS)
    col_scale = np.ones(IN_WIDTH, np.float32)
    for i in (2, 4, 6):
        col_scale[offs[i]:offs[i + 1]] = DEEPNORM_BETA
    col_scale[offs[8] + 2 * GDN_W:offs[9]] = DEEPNORM_BETA
    dtv = jnp.exp(jax.random.uniform(ks[8], (DEPTH, GDN_HEADS), f32,
                                     minval=math.log(1e-3), maxval=math.log(1e-1)))
    return {
        "x": jax.random.normal(ks[0], (BATCH, SEQ, D_MODEL), f32),
        "w_in": nrm(ks[1], (DEPTH, D_MODEL, IN_WIDTH), D_MODEL) * jnp.asarray(col_scale),
        "nsa_cmp_pos": 0.02 * jax.random.normal(ks[2], (DEPTH, 2, CMP_LEN, NSA_HEAD_DIM), f32),
        "nsa_cmp_w1": nrm(ks[3], (DEPTH, 2, CMP_LEN * NSA_HEAD_DIM, NSA_HEAD_DIM), CMP_LEN * NSA_HEAD_DIM),
        "nsa_cmp_w2": nrm(ks[4], (DEPTH, 2, NSA_HEAD_DIM, NSA_HEAD_DIM), NSA_HEAD_DIM),
        "w_nsa_out": nrm(ks[5], (DEPTH, NSA_Q_W, D_MODEL), NSA_Q_W, DEEPNORM_BETA),
        "gdn_conv_w": nrm(ks[6], (DEPTH, GDN_CONV, 3 * GDN_W), GDN_CONV),
        "gdn_a_log": jnp.log(jax.random.uniform(ks[7], (DEPTH, GDN_HEADS), f32, minval=1.0, maxval=16.0)),
        "gdn_dt_bias": dtv + jnp.log(-jnp.expm1(-dtv)),
        "gdn_norm_w": 1.0 + 0.02 * jax.random.normal(ks[9], (DEPTH, GDN_HEAD_DIM), f32),
        "w_gdn_out": nrm(ks[10], (DEPTH, GDN_W, D_MODEL), GDN_W, DEEPNORM_BETA),
        "w_o": nrm(ks[11], (DEPTH, D_MODEL, D_MODEL), D_MODEL, DEEPNORM_BETA),
        "ln1_g": 1.0 + 0.02 * jax.random.normal(ks[12], (DEPTH, D_MODEL), f32),
        "ln1_b": 0.02 * jax.random.normal(ks[13], (DEPTH, D_MODEL), f32),
        "ffn_w_up": nrm(ks[14], (DEPTH, D_MODEL, 2 * FFN_DIM), D_MODEL, DEEPNORM_BETA),
        "ffn_conv_w": nrm(ks[15], (DEPTH, FFN_CONV, 2 * FFN_DIM), FFN_CONV),
        "ffn_w_down": nrm(ks[16], (DEPTH, FFN_DIM, D_MODEL), FFN_DIM, DEEPNORM_BETA),
        "ln2_g": 1.0 + 0.02 * jax.random.normal(ks[17], (DEPTH, D_MODEL), f32),
        "ln2_b": 0.02 * jax.random.normal(ks[18], (DEPTH, D_MODEL), f32),
    }


def reference(x, w_in, nsa_cmp_pos, nsa_cmp_w1, nsa_cmp_w2, w_nsa_out, gdn_conv_w, gdn_a_log,
              gdn_dt_bias, gdn_norm_w, w_gdn_out, w_o, ln1_g, ln1_b, ffn_w_up, ffn_conv_w,
              ffn_w_down, ln2_g, ln2_b):
    for l in range(DEPTH):
        h = x @ w_in[l]
        (nsa_q, cmp_k, cmp_v, slc_k, slc_v, win_k, win_v, nsa_gate,
         gdn_qkv, gdn_beta, gdn_decay, gdn_gate, merge_gate) = _split_in(h)
        y_a = nsa_attention(nsa_q, cmp_k, cmp_v, slc_k, slc_v, win_k, win_v, nsa_gate,
                            nsa_cmp_pos[l], nsa_cmp_w1[l], nsa_cmp_w2[l]) @ w_nsa_out[l]
        y_b = gated_deltanet(gdn_qkv, gdn_beta, gdn_decay, gdn_gate, gdn_conv_w[l],
                             gdn_a_log[l], gdn_dt_bias[l], gdn_norm_w[l]) @ w_gdn_out[l]
        gate_a, gate_b = jnp.split(merge_gate, 2, axis=-1)
        mix = (jax.nn.sigmoid(gate_a) * y_a + jax.nn.sigmoid(gate_b) * y_b) @ w_o[l]
        x = layer_norm(DEEPNORM_ALPHA * x + mix, ln1_g[l], ln1_b[l])
        f = conv_ffn(x, ffn_w_up[l], ffn_conv_w[l], ffn_w_down[l])
        x = layer_norm(DEEPNORM_ALPHA * x + f, ln2_g[l], ln2_b[l])
    return x
```

```cpp
#include <hip/hip_runtime.h>
#include <hip/hip_cooperative_groups.h>
#include <cstdio>
#include <cstdint>
namespace cg = cooperative_groups;

#define LAS __attribute__((address_space(3)))
#define DI __device__ __forceinline__
typedef unsigned short bf16_t;
typedef short bf16x8 __attribute__((ext_vector_type(8)));
typedef short s16x4 __attribute__((ext_vector_type(4)));
typedef float f32x4 __attribute__((ext_vector_type(4)));
typedef float f32x16 __attribute__((ext_vector_type(16)));
typedef float f32x2 __attribute__((ext_vector_type(2)));
typedef unsigned u32x4 __attribute__((ext_vector_type(4)));
typedef unsigned u32x2 __attribute__((ext_vector_type(2)));
typedef __bf16 bf16x2_t __attribute__((ext_vector_type(2)));

constexpr int SEQ = 2048, BATCH = 8, DM = 1024, M = BATCH * SEQ;
constexpr int NIN = 5632;
constexpr int FF = 2816, FF2 = 5632;
constexpr float ALPHA = 1.189207115002721f;
constexpr float LOG2E = 1.4426950408889634f;
constexpr int LDS_BYTES = 147456;
constexpr size_t MiB = 1u << 20;
constexpr size_t WS_CTL = 0;
constexpr size_t WS_WIN = 1 * MiB, WS_WUP = 12 * MiB, WS_WDN = 23 * MiB, WS_WO = 29 * MiB, WS_WNSA = 31 * MiB, WS_WGDN = 32 * MiB;
constexpr size_t WS_W1C = 33 * MiB;
constexpr size_t WS_EGL = 33 * MiB + 512 * 1024;
constexpr size_t WS_KVC = 34 * MiB;
constexpr size_t WS_SMALL = 35 * MiB;
constexpr size_t WS_R32 = 37 * MiB;
constexpr size_t WS_H = 69 * MiB;
constexpr size_t WS_HQ = WS_H, WS_HKV = WS_H + 16 * MiB, WS_HG = WS_H + 40 * MiB, WS_HGG = WS_H + 88 * MiB, WS_HM = WS_H + 104 * MiB;
constexpr size_t WS_APERM = WS_H + 168 * MiB;
constexpr size_t WS_MIX = WS_HG;
constexpr size_t WS_HUP = WS_H;
constexpr size_t WS_HALO = 245 * MiB;
constexpr size_t WS_END = 256 * MiB;
constexpr size_t DO_WNEG = 0, DO_QS = 8u << 20, DO_KST = 16u << 20, DO_UT = 24u << 20;

DI float bf2f(unsigned short u) { return __uint_as_float((unsigned)u << 16); }
DI unsigned pk2(float lo, float hi) { f32x2 v = {lo, hi}; bf16x2_t b = __builtin_convertvector(v, bf16x2_t); return __builtin_bit_cast(unsigned, b); }
DI unsigned short f2bf(float f) { return (unsigned short)(pk2(f, 0.f) & 0xffffu); }
DI float sigmoidf_(float x) { return 1.f / (1.f + __expf(-x)); }
DI float siluf_(float x) { return x / (1.f + __expf(-x)); }
DI float wave_sum(float v) {
#pragma unroll
    for (int o = 1; o < 64; o <<= 1) v += __shfl_xor(v, o);
    return v;
}
DI int crow(int r, int hi) { return (r & 3) + 8 * (r >> 2) + 4 * hi; }
DI int posperm(int x) { return (x & ~31) + ((x >> 2) & 3) * 8 + ((x >> 4) & 1) * 4 + (x & 3); }
#define MFMA16(a, b, c) __builtin_amdgcn_mfma_f32_16x16x32_bf16((a), (b), (c), 0, 0, 0)
#define MFMA32(a, b, c) __builtin_amdgcn_mfma_f32_32x32x16_bf16((a), (b), (c), 0, 0, 0)

namespace pg8 {
constexpr int BM = 256, BK = 64, HALF = 128, HTB = HALF * BK * 2, STAGE_BYTES = 8 * HTB, NXCD = 8, WGM = 8;
__host__ __device__ __forceinline__ int lds_byte(int r, int c) { const int st = (r >> 4) * 2 + (c >> 5), rr = r & 15, cc = c & 31, ob = rr * 64 + cc * 2; return st * 1024 + (ob ^ (((ob >> 9) & 1) << 5)); }
__host__ __device__ __forceinline__ void stage_rc(int b, int& R, int& C) { const int st = b / 1024, sb = b % 1024, swz = sb ^ (((sb >> 9) & 1) << 5); R = (st >> 1) * 16 + swz / 64; C = (st & 1) * 32 + (swz % 64) / 2; }
__host__ __device__ __forceinline__ int perm32(int rho) { const int n = rho >> 4, i = rho & 15; return 8 * (i >> 2) + 4 * n + (i & 3); }
struct Unit { int pm, pn; };
struct Gemm { const bf16_t* A; const bf16_t* Bt; int M, N, K, lda; };
struct StaticOrder {
    int nM, nN, nwg, G, c;
    __host__ __device__ void init(int M_, int N_, int G_, int c_) { nM = M_ / BM; nN = N_ / BM; nwg = nM * nN; G = G_; c = c_; }
    __host__ __device__ bool next(int i, Unit& u) const {
        const long L = (long)i * G + c; if (L >= nwg) return false;
        int wgid = (int)L; { const int q = nwg / NXCD, r = nwg % NXCD, xcd = wgid % NXCD, off = wgid / NXCD; wgid = (xcd < r ? xcd * (q + 1) : r * (q + 1) + (xcd - r) * q) + off; }
        const int nig = WGM * nN, gid = wgid / nig, fm = gid * WGM, gsz = (nM - fm) < WGM ? (nM - fm) : WGM;
        u.pm = fm + ((wgid % nig) % gsz); u.pn = (wgid % nig) / gsz; return true;
    }
};
template <class Epi>
__device__ __forceinline__ void gemm_phase(LAS unsigned char* lds, const Gemm g, const StaticOrder& S, const Epi& E) {
    const int tid = threadIdx.x, wid = __builtin_amdgcn_readfirstlane(tid >> 6), lane = tid & 63, wr = wid >> 2, wc = wid & 3, fr = lane & 15, fq = lane >> 4;
    const int K = g.K, nt = K / BK, lda = g.lda;
    unsigned voffA[2], voffB[2];
#pragma unroll
    for (int i = 0; i < 2; ++i) { int R, C; stage_rc(tid * 16 + i * 8192, R, C); const int Rb = Epi::PERM ? ((R & ~31) + perm32(R & 31)) : R;
        voffA[i] = (unsigned)(R * lda + C) * 2u; voffB[i] = (unsigned)(Rb * K + C) * 2u; }
    const size_t kstep = (size_t)(BK * 2);
    const size_t hstepA = (size_t)HALF * lda * 2, hstepB = (size_t)HALF * K * 2;
    const size_t tstepA = 2 * hstepA, tstepB = 2 * hstepB;
    const unsigned ldsw = (unsigned)wid * 1024u;
    const int aoff = lds_byte(wr * 64 + fr, fq * 8), boff = lds_byte(wc * 32 + fr, fq * 8);
#define PG8_SA(b, h) (((b) * 2 + (h)) * HTB)
#define PG8_SB(b, h) ((4 + (b) * 2 + (h)) * HTB)
#define PG8_STAGE(bufoff, gbase, voff) do { _Pragma("unroll") for (int _i = 0; _i < 2; ++_i) \
        __builtin_amdgcn_global_load_lds((const unsigned*)((const char*)(gbase) + (voff)[_i]), (LAS unsigned*)(lds + (bufoff) + ldsw + _i * 8192), 16, 0, 0); } while (0)
#define PG8_LDA(dst, b, h) do { _Pragma("unroll") for (int m = 0; m < 4; ++m) _Pragma("unroll") for (int k = 0; k < 2; ++k) dst[m][k] = *(const LAS bf16x8*)(lds + PG8_SA(b, h) + aoff + m * 2048 + k * 1024); } while (0)
#define PG8_LDB(dst, b, h) do { _Pragma("unroll") for (int n = 0; n < 2; ++n) _Pragma("unroll") for (int k = 0; k < 2; ++k) dst[n][k] = *(const LAS bf16x8*)(lds + PG8_SB(b, h) + boff + n * 2048 + k * 1024); } while (0)
#define PG8_MMA(ai, bj, At, Bt) do { __builtin_amdgcn_s_setprio(1); _Pragma("unroll") for (int m = 0; m < 4; ++m) _Pragma("unroll") for (int n = 0; n < 2; ++n) _Pragma("unroll") for (int k = 0; k < 2; ++k) \
        acc[ai][bj][m][n] = __builtin_amdgcn_mfma_f32_16x16x32_bf16(Bt[n][k], At[m][k], acc[ai][bj][m][n], 0, 0, 0); __builtin_amdgcn_s_setprio(0); } while (0)
#define PG8_WAIT_V(n) asm volatile("s_waitcnt vmcnt(" #n ")" ::: "memory")
#define PG8_WAIT_L(n) asm volatile("s_waitcnt lgkmcnt(" #n ")" ::: "memory")
#define PG8_BAR __builtin_amdgcn_s_barrier()
#define PG8_SCHED __builtin_amdgcn_sched_barrier(0)
    Unit cur, nxt; int ui = 0;
    if (!S.next(0, cur)) return;
    f32x4 acc[2][2][4][2];
#pragma unroll
    for (int a = 0; a < 2; ++a)
#pragma unroll
        for (int b = 0; b < 2; ++b)
#pragma unroll
            for (int m = 0; m < 4; ++m)
#pragma unroll
                for (int n = 0; n < 2; ++n) acc[a][b][m][n] = (f32x4){0.f, 0.f, 0.f, 0.f};
    bf16x8 At[4][2], B0[2][2], B1[2][2];
    const char* cA = (const char*)g.A + (size_t)cur.pm * tstepA; const char* cB = (const char*)g.Bt + (size_t)cur.pn * tstepB;
    PG8_STAGE(PG8_SB(0, 0), cB, voffB); PG8_STAGE(PG8_SB(0, 1), cB + hstepB, voffB); PG8_STAGE(PG8_SA(0, 0), cA, voffA); PG8_STAGE(PG8_SA(0, 1), cA + hstepA, voffA);
    if (wr == 1) PG8_BAR;
    PG8_WAIT_V(2); PG8_BAR;
    PG8_STAGE(PG8_SB(1, 0), cB + kstep, voffB); PG8_STAGE(PG8_SA(1, 0), cA + kstep, voffA); PG8_STAGE(PG8_SB(1, 1), cB + hstepB + kstep, voffB);
    PG8_WAIT_V(6); PG8_BAR;
    for (;;) {
        const bool has_next = S.next(ui + 1, nxt);
        const char* nA = has_next ? (const char*)g.A + (size_t)nxt.pm * tstepA : cA; const char* nB = has_next ? (const char*)g.Bt + (size_t)nxt.pn * tstepB : cB;
        for (int t = 0; t < nt; t += 2) {
            const bool last = (t == nt - 2);
            const char* a1 = cA + (size_t)(t + 1) * kstep;
            const char* a2 = last ? nA : cA + (size_t)(t + 2) * kstep; const char* b2 = last ? nB : cB + (size_t)(t + 2) * kstep;
            const char* a3 = a2 + kstep; const char* b3 = b2 + kstep;
            PG8_LDB(B0, 0, 0); PG8_LDB(B1, 0, 1); PG8_SCHED; PG8_LDA(At, 0, 0); PG8_STAGE(PG8_SA(1, 1), a1 + hstepA, voffA);
            PG8_WAIT_V(8); PG8_WAIT_L(0); PG8_BAR; PG8_MMA(0, 0, At, B0); PG8_MMA(0, 1, At, B1); PG8_BAR; PG8_SCHED;
            PG8_LDA(At, 0, 1); PG8_STAGE(PG8_SB(0, 0), b2, voffB); PG8_STAGE(PG8_SB(0, 1), b2 + hstepB, voffB); PG8_STAGE(PG8_SA(0, 0), a2, voffA);
            PG8_WAIT_V(8); PG8_WAIT_L(0); PG8_BAR; PG8_MMA(1, 0, At, B0); PG8_MMA(1, 1, At, B1); PG8_BAR; PG8_SCHED;
            PG8_LDB(B0, 1, 0); PG8_LDB(B1, 1, 1); PG8_SCHED; PG8_LDA(At, 1, 0); PG8_STAGE(PG8_SA(0, 1), a2 + hstepA, voffA);
            PG8_WAIT_V(8); PG8_WAIT_L(0); PG8_BAR; PG8_MMA(0, 0, At, B0); PG8_MMA(0, 1, At, B1); PG8_BAR; PG8_SCHED;
            PG8_LDA(At, 1, 1); PG8_STAGE(PG8_SB(1, 0), b3, voffB); PG8_STAGE(PG8_SB(1, 1), b3 + hstepB, voffB); PG8_STAGE(PG8_SA(1, 0), a3, voffA);
            PG8_WAIT_V(8); PG8_WAIT_L(0); PG8_BAR; PG8_MMA(1, 0, At, B0); PG8_MMA(1, 1, At, B1); PG8_BAR; PG8_SCHED;
        }
        if (wr == 0) PG8_BAR;
        E(acc, cur, wr, wc, fr, fq);
        if (!has_next) break;
#pragma unroll
        for (int a = 0; a < 2; ++a)
#pragma unroll
            for (int b = 0; b < 2; ++b)
#pragma unroll
                for (int m = 0; m < 4; ++m)
#pragma unroll
                    for (int n = 0; n < 2; ++n) acc[a][b][m][n] = (f32x4){0.f, 0.f, 0.f, 0.f};
        cur = nxt; cA = nA; cB = nB; ++ui;
        if (wr == 1) PG8_BAR;
    }
    PG8_WAIT_V(0);
    PG8_BAR;
#undef PG8_SA
#undef PG8_SB
#undef PG8_STAGE
#undef PG8_LDA
#undef PG8_LDB
#undef PG8_MMA
#undef PG8_WAIT_V
#undef PG8_WAIT_L
#undef PG8_BAR
#undef PG8_SCHED
}
}
using pg8::Unit;
typedef f32x4 AccT[2][2][4][2];

DI u32x4 pack8(const f32x4& v0, const f32x4& v1) { u32x4 w; w.x = pk2(v0[0], v0[1]); w.y = pk2(v0[2], v0[3]); w.z = pk2(v1[0], v1[1]); w.w = pk2(v1[2], v1[3]); return w; }
struct EpiH {
    static constexpr bool PERM = true;
    bf16_t *hq, *hkv, *hg, *hgg, *hm; float* small;
    DI void operator()(const AccT& acc, const Unit& u, int wr, int wc, int fr, int fq) const {
        const int pn = u.pn; const int row0 = u.pm * 256 + wr * 64 + fr;
        if (pn == 21) {
            if (wc == 0) {
#pragma unroll
                for (int ai = 0; ai < 2; ++ai)
#pragma unroll
                    for (int m = 0; m < 4; ++m) { float* rp = small + (size_t)(row0 + ai * 128 + m * 16) * 32 + 8 * fq;
                        *(f32x4*)rp = acc[ai][0][m][0]; *(f32x4*)(rp + 4) = acc[ai][0][m][1]; }
            }
            return;
        }
        bf16_t* base; int ldc, ct;
        if (pn < 2) { base = hq; ldc = 512; ct = pn; } else if (pn < 5) { base = hkv; ldc = 768; ct = pn - 2; } else if (pn < 11) { base = hg; ldc = 1536; ct = pn - 5; }
        else if (pn < 13) { base = hgg; ldc = 512; ct = pn - 11; } else { base = hm; ldc = 2048; ct = pn - 13; }
        const int col0 = ct * 256 + wc * 32 + 8 * fq;
#pragma unroll
        for (int ai = 0; ai < 2; ++ai)
#pragma unroll
            for (int m = 0; m < 4; ++m) { bf16_t* rowp = base + (size_t)(row0 + ai * 128 + m * 16) * ldc + col0;
#pragma unroll
                for (int bj = 0; bj < 2; ++bj) *(u32x4*)(rowp + bj * 128) = pack8(acc[ai][bj][m][0], acc[ai][bj][m][1]); }
    }
};
template <int MODE> struct EpiGate {
    static constexpr bool PERM = true;
    const bf16_t* hm; bf16_t* mix;
    DI void operator()(const AccT& acc, const Unit& u, int wr, int wc, int fr, int fq) const {
        const int row0 = u.pm * 256 + wr * 64 + fr, col0 = u.pn * 256 + wc * 32 + 8 * fq;
#pragma unroll
        for (int ai = 0; ai < 2; ++ai)
#pragma unroll
            for (int m = 0; m < 4; ++m) { const size_t row = (size_t)(row0 + ai * 128 + m * 16);
#pragma unroll
                for (int bj = 0; bj < 2; ++bj) { const int col = col0 + bj * 128;
                    const u32x4 gv = *(const u32x4*)(hm + row * 2048 + MODE * 1024 + col);
                    u32x4 old = {0u, 0u, 0u, 0u}; if (MODE == 1) old = *(const u32x4*)(mix + row * 1024 + col);
                    float o[8];
#pragma unroll
                    for (int e = 0; e < 8; ++e) { const unsigned gw = gv[e >> 1], ow = old[e >> 1];
                        const float gg = (e & 1) ? __uint_as_float(gw & 0xffff0000u) : __uint_as_float(gw << 16);
                        const float oo = (e & 1) ? __uint_as_float(ow & 0xffff0000u) : __uint_as_float(ow << 16);
                        const float a = (e < 4) ? acc[ai][bj][m][0][e & 3] : acc[ai][bj][m][1][e & 3];
                        o[e] = sigmoidf_(gg) * a + (MODE == 1 ? oo : 0.f); }
                    u32x4 w; w.x = pk2(o[0], o[1]); w.y = pk2(o[2], o[3]); w.z = pk2(o[4], o[5]); w.w = pk2(o[6], o[7]);
                    *(u32x4*)(mix + row * 1024 + col) = w; } }
    }
};
struct EpiZ {
    static constexpr bool PERM = false;
    const float* base; float* out;
    DI void operator()(const AccT& acc, const Unit& u, int wr, int wc, int fr, int fq) const {
        const int row0 = u.pm * 256 + wr * 64 + fr, col0 = u.pn * 256 + wc * 32 + 4 * fq;
#pragma unroll
        for (int ai = 0; ai < 2; ++ai)
#pragma unroll
            for (int m = 0; m < 4; ++m) { const size_t off = (size_t)(row0 + ai * 128 + m * 16) * 1024 + col0;
#pragma unroll
                for (int bj = 0; bj < 2; ++bj)
#pragma unroll
                    for (int n = 0; n < 2; ++n) { const f32x4 bs = *(const f32x4*)(base + off + bj * 128 + n * 16); *(f32x4*)(out + off + bj * 128 + n * 16) = bs * ALPHA + acc[ai][bj][m][n]; } }
    }
};
struct EpiUp {
    static constexpr bool PERM = true;
    bf16_t* hup; bf16_t* halo;
    DI void operator()(const AccT& acc, const Unit& u, int wr, int wc, int fr, int fq) const {
        const int row0 = u.pm * 256 + wr * 64 + fr, col0 = u.pn * 256 + wc * 32 + 8 * fq;
#pragma unroll
        for (int ai = 0; ai < 2; ++ai)
#pragma unroll
            for (int m = 0; m < 4; ++m) { const int row = row0 + ai * 128 + m * 16; bf16_t* rowp = hup + (size_t)row * FF2 + col0;
#pragma unroll
                for (int bj = 0; bj < 2; ++bj) { const u32x4 w = pack8(acc[ai][bj][m][0], acc[ai][bj][m][1]); *(u32x4*)(rowp + bj * 128) = w;
                    if ((m & 1) && fr >= 14) *(u32x4*)(halo + ((size_t)(row >> 5) * 2 + (row & 1)) * FF2 + col0 + bj * 128) = w; } }
    }
};

struct Params {
    const float *x, *w_in, *cmp_pos, *cmp_w1, *cmp_w2, *w_nsa, *gdn_conv, *a_log, *dt_bias, *norm_w, *w_gdn, *w_o, *ln1g, *ln1b, *w_up, *ffn_conv, *w_dn, *ln2g, *ln2b;
    float* out; unsigned char* ws; int ph_lo, ph_hi;
};

DI void tr_item(const float* W, int K, int Nsrc, int c0, int width, bf16_t* WT, int r0, LAS float* scr, int item, int lane) {
    const int nblk = (width + 31) >> 5, kb = item / nblk, nb = item - kb * nblk, k0 = 64 * kb, n0 = 32 * nb;
    const bool cin = (n0 + (lane & 31)) < width;
#pragma unroll 8
    for (int i = 0; i < 32; ++i) { const int kk = 2 * i + (lane >> 5); scr[kk * 33 + (lane & 31)] = cin ? W[(size_t)(k0 + kk) * Nsrc + c0 + n0 + (lane & 31)] : 0.f; }
    asm volatile("s_waitcnt lgkmcnt(0)" ::: "memory");
    const int c = lane & 7;
#pragma unroll
    for (int j = 0; j < 4; ++j) { const int n = (lane >> 3) + 8 * j; const LAS float* s = scr + (8 * c) * 33 + n;
        u32x4 o; o.x = pk2(s[0 * 33], s[1 * 33]); o.y = pk2(s[2 * 33], s[3 * 33]); o.z = pk2(s[4 * 33], s[5 * 33]); o.w = pk2(s[6 * 33], s[7 * 33]);
        if (n0 + n < width) *(u32x4*)(WT + (size_t)(r0 + n0 + n) * K + k0 + 8 * c) = o; }
    asm volatile("s_waitcnt lgkmcnt(0)" ::: "memory");
}
DI void p0_prologue(const Params& p, LAS unsigned char* lds, int wave, int lane) {
    LAS float* scr = (LAS float*)(lds + wave * 16384);
    const int gw = blockIdx.x * 8 + wave, NGW = gridDim.x * 8;
    bf16_t* win = (bf16_t*)(p.ws + WS_WIN);
    constexpr int TOTAL = 16 * 171 + 16 * 176 + 44 * 32 + 16 * 32 + 8 * 32 + 8 * 32 + 2 * 32 * 2;
#define SEG(W, K, NS, C0, WD, WT, R0) { const int ni = ((K) / 64) * (((WD) + 31) / 32); if (r < ni) { tr_item(W, K, NS, C0, WD, WT, R0, scr, r, lane); continue; } r -= ni; }
    for (int it = gw; it < TOTAL; it += NGW) {
        int r = it;
        SEG(p.w_in, 1024, 5408, 0, 512, win, 0)
        SEG(p.w_in, 1024, 5408, 512, 768, win, 512)
        SEG(p.w_in, 1024, 5408, 1304, 1536, win, 1280)
        SEG(p.w_in, 1024, 5408, 2848, 512, win, 2816)
        SEG(p.w_in, 1024, 5408, 3360, 2048, win, 3328)
        SEG(p.w_in, 1024, 5408, 1280, 24, win, 5376)
        SEG(p.w_in, 1024, 5408, 2840, 4, win, 5400)
        SEG(p.w_in, 1024, 5408, 2844, 4, win, 5404)
        SEG(p.w_up, 1024, 5632, 0, 5632, (bf16_t*)(p.ws + WS_WUP), 0)
        SEG(p.w_dn, 2816, 1024, 0, 1024, (bf16_t*)(p.ws + WS_WDN), 0)
        SEG(p.w_o, 1024, 1024, 0, 1024, (bf16_t*)(p.ws + WS_WO), 0)
        SEG(p.w_nsa, 512, 1024, 0, 1024, (bf16_t*)(p.ws + WS_WNSA), 0)
        SEG(p.w_gdn, 512, 1024, 0, 1024, (bf16_t*)(p.ws + WS_WGDN), 0)
        SEG(p.cmp_w1, 2048, 64, 0, 64, (bf16_t*)(p.ws + WS_W1C), 0)
        SEG(p.cmp_w1 + 2048 * 64, 2048, 64, 0, 64, (bf16_t*)(p.ws + WS_W1C) + 64 * 2048, 0)
    }
#undef SEG
    const int gtid = blockIdx.x * 512 + threadIdx.x, gsz = gridDim.x * 512;
    for (int i = gtid; i < 224 * 1024 / 8; i += gsz) *(u32x4*)(win + (size_t)5408 * 1024 + (size_t)i * 8) = (u32x4){0u, 0u, 0u, 0u};
    bf16_t* xb = (bf16_t*)(p.ws + WS_R32);
    for (int i = gtid; i < M * DM / 8; i += gsz) { const f32x4 a = *(const f32x4*)(p.x + (size_t)i * 8), b = *(const f32x4*)(p.x + (size_t)i * 8 + 4); *(u32x4*)(xb + (size_t)i * 8) = pack8(a, b); }
}

DI void cmp_task(const Params& p, LAS unsigned char* lds, int task, int wave, int lane) {
    const int rt = task & 7, g = (task >> 3) & 1, b = (task >> 4) & 7, i = task >> 7;
    const bf16_t* hkv = (const bf16_t*)(p.ws + WS_HKV);
    const bf16_t* w1t = (const bf16_t*)(p.ws + WS_W1C) + (size_t)i * 64 * 2048;
    const float* pos = p.cmp_pos + i * 2048;
    LAS float* red = (LAS float*)lds;
    LAS float* gl = (LAS float*)(lds + 32768);
    const int row = lane & 15, quad = lane >> 4;
    int n = 16 * rt + row; if (n > 126) n = 126;
    f32x4 acc[4];
#pragma unroll
    for (int nt = 0; nt < 4; ++nt) acc[nt] = (f32x4){0.f, 0.f, 0.f, 0.f};
#pragma unroll
    for (int ks = 0; ks < 8; ++ks) {
        const int l = 4 * wave + (ks >> 1), d = (ks & 1) * 32 + quad * 8;
        const u32x4 raw = *(const u32x4*)(hkv + (size_t)(b * SEQ + 16 * n + l) * 768 + i * 128 + g * 64 + d);
        const f32x4 p0 = *(const f32x4*)(pos + l * 64 + d), p1 = *(const f32x4*)(pos + l * 64 + d + 4);
        float v[8];
#pragma unroll
        for (int e = 0; e < 8; ++e) { const unsigned w = raw[e >> 1]; v[e] = ((e & 1) ? __uint_as_float(w & 0xffff0000u) : __uint_as_float(w << 16)) + (e < 4 ? p0[e & 3] : p1[e & 3]); }
        u32x4 aw; aw.x = pk2(v[0], v[1]); aw.y = pk2(v[2], v[3]); aw.z = pk2(v[4], v[5]); aw.w = pk2(v[6], v[7]);
        const bf16x8 a = __builtin_bit_cast(bf16x8, aw);
        const int k = wave * 256 + ks * 32 + quad * 8;
#pragma unroll
        for (int nt = 0; nt < 4; ++nt) { const bf16x8 bb = *(const bf16x8*)(w1t + (size_t)(nt * 16 + row) * 2048 + k); acc[nt] = MFMA16(a, bb, acc[nt]); }
    }
#pragma unroll
    for (int nt = 0; nt < 4; ++nt)
#pragma unroll
        for (int jj = 0; jj < 4; ++jj) red[(wave * 16 + quad * 4 + jj) * 64 + nt * 16 + row] = acc[nt][jj];
    __syncthreads();
    const int tid = threadIdx.x;
#pragma unroll
    for (int e = 0; e < 2; ++e) { const int o = tid + 512 * e; float s = 0.f;
#pragma unroll
        for (int w = 0; w < 8; ++w) s += red[w * 1024 + o];
        const float u = 0.7978845608028654f * (s + 0.044715f * s * s * s);
        gl[o] = 0.5f * s * (1.f + tanhf(u)); }
    __syncthreads();
    const float* w2 = p.cmp_w2 + i * 4096;
    float* kvc = (float*)(p.ws + WS_KVC) + (size_t)((i * 16 + b * 2 + g) * 128) * 64;
#pragma unroll
    for (int e = 0; e < 2; ++e) { const int o = tid + 512 * e, r = o >> 6, j = o & 63; float s = 0.f;
#pragma unroll 8
        for (int k = 0; k < 64; ++k) s += gl[r * 64 + k] * w2[k * 64 + j];
        const int nn = 16 * rt + r; kvc[(size_t)nn * 64 + j] = (nn <= 126) ? s : 0.f; }
    __syncthreads();
}

constexpr int GP_XQ = 0, GP_XK = 33024, GP_KB = 66048, GP_QB = 83456, GP_VBT = 100864, GP_KGT = 119296, GP_MISC = 137728;
constexpr int GP_MM = 0, GP_TB = 33024;
DI void gdn_prep_task(const Params& p, LAS unsigned char* lds, int task, int wave, int lane) {
    const int tid = threadIdx.x;
    const int n = task & 31, h = (task >> 5) & 3, b = task >> 7;
    const int rowb = b * SEQ + n * 64;
    const bf16_t* hg = (const bf16_t*)(p.ws + WS_HG);
    const float* small = (const float*)(p.ws + WS_SMALL);
    LAS float* XQ = (LAS float*)(lds + GP_XQ); LAS float* XK = (LAS float*)(lds + GP_XK);
    LAS bf16_t* KB = (LAS bf16_t*)(lds + GP_KB); LAS bf16_t* QB = (LAS bf16_t*)(lds + GP_QB);
    LAS bf16_t* VBT = (LAS bf16_t*)(lds + GP_VBT); LAS bf16_t* KGT = (LAS bf16_t*)(lds + GP_KGT);
    LAS float* betaL = (LAS float*)(lds + GP_MISC); LAS float* gcL = betaL + 64; LAS float* rsqL = betaL + 128; LAS float* rskL = betaL + 192;
    LAS float* MMf = (LAS float*)(lds + GP_MM); LAS bf16_t* TB = (LAS bf16_t*)(lds + GP_TB);
    bf16_t* dob = (bf16_t*)p.out;
    bf16_t* wneg_g = dob + DO_WNEG + (size_t)task * 8192; bf16_t* qs_g = dob + DO_QS + (size_t)task * 8192;
    bf16_t* kst_g = dob + DO_KST + (size_t)task * 8192; bf16_t* ut_g = dob + DO_UT + (size_t)task * 8192;
    bf16_t* ap_g = (bf16_t*)(p.ws + WS_APERM) + (size_t)task * 4096;
    if (wave == 0) {
        const float braw = small[(size_t)(rowb + lane) * 32 + 24 + h], draw = small[(size_t)(rowb + lane) * 32 + 28 + h];
        const float z = draw + p.dt_bias[h];
        const float sp = fmaxf(z, 0.f) + log1pf(__expf(-fabsf(z)));
        float gc = -__expf(p.a_log[h]) * sp;
#pragma unroll
        for (int o = 1; o < 64; o <<= 1) { const float t = __shfl_up(gc, o); if (lane >= o) gc += t; }
        betaL[lane] = sigmoidf_(braw); gcL[lane] = gc;
        if (lane == 63) ((float*)(p.ws + WS_EGL))[task] = __expf(gc);
    }
    __syncthreads();
    for (int item = tid; item < 768; item += 512) {
        const int c = item % 384, th = item / 384, seg = c >> 7, dcol = c & 127, gcol = seg * 512 + h * 128 + dcol;
        const float w0 = p.gdn_conv[gcol], w1 = p.gdn_conv[1536 + gcol], w2 = p.gdn_conv[3072 + gcol], w3 = p.gdn_conv[4608 + gcol];
        const int ts0 = n * 64 + th * 32;
        const bf16_t* src = hg + (size_t)(b * SEQ) * 1536 + gcol;
        float x0 = (ts0 >= 3) ? bf2f(src[(size_t)(ts0 - 3) * 1536]) : 0.f, x1 = (ts0 >= 2) ? bf2f(src[(size_t)(ts0 - 2) * 1536]) : 0.f, x2 = (ts0 >= 1) ? bf2f(src[(size_t)(ts0 - 1) * 1536]) : 0.f;
#pragma unroll 8
        for (int tl = 0; tl < 32; ++tl) {
            const float x3 = bf2f(src[(size_t)(ts0 + tl) * 1536]);
            const float y = siluf_(w0 * x0 + w1 * x1 + w2 * x2 + w3 * x3);
            const int t = th * 32 + tl;
            if (seg == 0) XQ[t * 129 + dcol] = y; else if (seg == 1) XK[t * 129 + dcol] = y; else VBT[dcol * 72 + t] = f2bf(y * betaL[t]);
            x0 = x1; x1 = x2; x2 = x3;
        }
    }
    __syncthreads();
    { const int mat = tid >> 8, row = (tid >> 2) & 63, part = tid & 3; LAS float* X = mat ? XK : XQ; float s = 0.f;
#pragma unroll 8
      for (int d = 0; d < 32; ++d) { const float v = X[row * 129 + part * 32 + d]; s += v * v; }
      s += __shfl_xor(s, 1); s += __shfl_xor(s, 2);
      if (part == 0) { if (mat) rskL[row] = rsqrtf(s + 1e-6f); else rsqL[row] = rsqrtf(s + 1e-6f) * 0.08838834764831845f; } }
    __syncthreads();
    const float glast = gcL[63];
    for (int e = tid; e < 8192; e += 512) { const int t = e >> 7, d = e & 127;
        const float kn = XK[t * 129 + d] * rskL[t], qn = XQ[t * 129 + d] * rsqL[t];
        KB[t * 136 + d] = f2bf(kn); QB[t * 136 + d] = f2bf(qn);
        qs_g[t * 128 + posperm(d)] = f2bf(qn * __expf(gcL[t])); }
    for (int e = tid; e < 8192; e += 512) { const int d = e >> 6, t = e & 63;
        const float kn = XK[t * 129 + d] * rskL[t];
        KGT[d * 72 + t] = f2bf(kn * betaL[t] * __expf(gcL[t]));
        kst_g[d * 64 + posperm(t)] = f2bf(kn * __expf(glast - gcL[t])); }
    __syncthreads();
    { const int row = lane & 15, quad = lane >> 4;
#pragma unroll
      for (int jb = 0; jb < 2; ++jb) { const int tt = wave * 2 + jb, ti = tt >> 2, tj = tt & 3;
        f32x4 ak = {0.f, 0.f, 0.f, 0.f}, aq = {0.f, 0.f, 0.f, 0.f};
        if (tj <= ti) {
#pragma unroll
            for (int pp = 0; pp < 4; ++pp) { const bf16x8 bk = *(const LAS bf16x8*)(KB + (16 * tj + row) * 136 + 32 * pp + 8 * quad);
                const bf16x8 a_k = *(const LAS bf16x8*)(KB + (16 * ti + row) * 136 + 32 * pp + 8 * quad), a_q = *(const LAS bf16x8*)(QB + (16 * ti + row) * 136 + 32 * pp + 8 * quad);
                ak = MFMA16(a_k, bk, ak); aq = MFMA16(a_q, bk, aq); } }
        const int j = 16 * tj + row; const float gj = gcL[j];
#pragma unroll
        for (int jj = 0; jj < 4; ++jj) { const int i = 16 * ti + 4 * quad + jj; const float dec = __expf(fminf(gcL[i] - gj, 0.f));
            MMf[i * 68 + j] = (j < i) ? betaL[i] * ak[jj] * dec : 0.f;
            ap_g[i * 64 + posperm(j)] = f2bf((j <= i) ? aq[jj] * dec : 0.f); } } }
    __syncthreads();
    if (wave == 0) {
        float t[64];
#pragma unroll
        for (int i = 0; i < 64; ++i) {
            float a = (i == lane) ? 1.f : 0.f;
#pragma unroll
            for (int j4 = 0; j4 < (i + 3) / 4; ++j4) { const f32x4 m4 = *(const LAS f32x4*)(MMf + i * 68 + 4 * j4);
#pragma unroll
                for (int e = 0; e < 4; ++e) if (4 * j4 + e < i) a -= m4[e] * t[4 * j4 + e]; }
            t[i] = a;
        }
        asm volatile("s_waitcnt lgkmcnt(0)" ::: "memory");
#pragma unroll
        for (int i = 0; i < 64; ++i) TB[i * 72 + lane] = f2bf(t[i]);
    }
    __syncthreads();
    { const int row = lane & 15, quad = lane >> 4;
      f32x4 au[4], aw[4];
#pragma unroll
      for (int i = 0; i < 4; ++i) { au[i] = (f32x4){0.f, 0.f, 0.f, 0.f}; aw[i] = (f32x4){0.f, 0.f, 0.f, 0.f}; }
#pragma unroll
      for (int pp = 0; pp < 2; ++pp) {
          const bf16x8 bv = *(const LAS bf16x8*)(VBT + (16 * wave + row) * 72 + 32 * pp + 8 * quad);
          const bf16x8 akg = *(const LAS bf16x8*)(KGT + (16 * wave + row) * 72 + 32 * pp + 8 * quad);
#pragma unroll
          for (int i = 0; i < 4; ++i) { const bf16x8 tb = *(const LAS bf16x8*)(TB + (16 * i + row) * 72 + 32 * pp + 8 * quad);
              au[i] = MFMA16(tb, bv, au[i]);
              aw[i] = MFMA16(akg, tb, aw[i]); }
      }
#pragma unroll
      for (int i = 0; i < 4; ++i) {
          u32x2 uw; uw.x = pk2(au[i][0], au[i][1]); uw.y = pk2(au[i][2], au[i][3]);
          *(u32x2*)(ut_g + (16 * wave + row) * 64 + 16 * i + 4 * quad) = uw;
          u32x2 ww; ww.x = pk2(-aw[i][0], -aw[i][1]); ww.y = pk2(-aw[i][2], -aw[i][3]);
          *(u32x2*)(wneg_g + (16 * i + row) * 128 + 32 * (wave >> 1) + 8 * quad + 4 * (wave & 1)) = ww; } }
    __syncthreads();
}

constexpr int GS_BUF = 62464, GS_QS = 17408, GS_A = 34816, GS_KST = 44032, GS_PART = 2 * GS_BUF;
DI void gdn_scan(const Params& p, LAS unsigned char* lds, int bh, int wave, int lane) {
    const int tid = threadIdx.x, b = bh >> 2, h = bh & 3;
    const bf16_t* dob = (const bf16_t*)p.out;
    const bf16_t* hgg = (const bf16_t*)(p.ws + WS_HGG);
    const float* egl = (const float*)(p.ws + WS_EGL) + bh * 32;
    bf16_t* gdn_o = (bf16_t*)(p.ws + WS_R32) + (size_t)M * 512;
    LAS float* part = (LAS float*)(lds + GS_PART);
    const int col = lane & 15, quad = lane >> 4, n0 = 16 * wave;
    const float nw = p.norm_w[n0 + col];
    unsigned goff[7], loff[7];
#pragma unroll
    for (int k = 0; k < 7; ++k) { const int pc = tid + 512 * k;
        if (k < 2) { goff[k] = (unsigned)(DO_WNEG) + pc * 8; loff[k] = (pc >> 4) * 272 + (pc & 15) * 16; }
        else if (k < 4) { const int q = pc - 1024; goff[k] = (unsigned)(DO_QS) + q * 8; loff[k] = GS_QS + (q >> 4) * 272 + (q & 15) * 16; }
        else if (k < 5) { const int q = pc - 2048; goff[k] = 0xffffffffu; loff[k] = GS_A + (q >> 3) * 144 + (q & 7) * 16; }
        else { const int q = pc - 2560; goff[k] = (unsigned)(DO_KST) + q * 8; loff[k] = GS_KST + (q >> 3) * 144 + (q & 7) * 16; } }
    const bf16_t* ap_base = (const bf16_t*)(p.ws + WS_APERM);
    u32x4 stg[7];
#define GS_LOAD(ch) do { const size_t cb = (size_t)(ch) * 8192; _Pragma("unroll") for (int k = 0; k < 7; ++k) { \
        if (k == 4) stg[k] = *(const u32x4*)(ap_base + (size_t)(ch) * 4096 + (tid + 512 * 4 - 2048) * 8); else stg[k] = *(const u32x4*)(dob + cb + goff[k]); } } while (0)
#define GS_STORE(bufi) do { _Pragma("unroll") for (int k = 0; k < 7; ++k) *(LAS u32x4*)(lds + (bufi) * GS_BUF + loff[k]) = stg[k]; } while (0)
    f32x4 S[8];
#pragma unroll
    for (int t = 0; t < 8; ++t) S[t] = (f32x4){0.f, 0.f, 0.f, 0.f};
    const int ch0 = bh * 32;
    GS_LOAD(ch0); GS_STORE(0);
    __syncthreads();
    for (int n = 0; n < 32; ++n) {
        const int ch = ch0 + n;
        if (n + 1 < 32) GS_LOAD(ch + 1);
        const LAS unsigned char* buf = lds + (n & 1) * GS_BUF;
        f32x4 V[4], O[4];
        const bf16_t* utp = dob + DO_UT + (size_t)ch * 8192 + (n0 + col) * 64 + 4 * quad;
        u32x2 uraw[4];
#pragma unroll
        for (int i = 0; i < 4; ++i) uraw[i] = *(const u32x2*)(utp + 16 * i);
        const size_t orow0 = (size_t)(b * SEQ + n * 64);
        unsigned short graw[16];
#pragma unroll
        for (int i = 0; i < 4; ++i)
#pragma unroll
            for (int jj = 0; jj < 4; ++jj) graw[i * 4 + jj] = hgg[(orow0 + 16 * i + 4 * quad + jj) * 512 + h * 128 + n0 + col];
        const float eg = egl[n];
#pragma unroll
        for (int i = 0; i < 4; ++i) { V[i] = (f32x4){__uint_as_float(uraw[i].x << 16), __uint_as_float(uraw[i].x & 0xffff0000u), __uint_as_float(uraw[i].y << 16), __uint_as_float(uraw[i].y & 0xffff0000u)};
            O[i] = (f32x4){0.f, 0.f, 0.f, 0.f}; }
        bf16x8 Sop[4];
#pragma unroll
        for (int pp = 0; pp < 4; ++pp) { u32x4 w; w.x = pk2(S[2 * pp][0], S[2 * pp][1]); w.y = pk2(S[2 * pp][2], S[2 * pp][3]); w.z = pk2(S[2 * pp + 1][0], S[2 * pp + 1][1]); w.w = pk2(S[2 * pp + 1][2], S[2 * pp + 1][3]); Sop[pp] = __builtin_bit_cast(bf16x8, w); }
#pragma unroll
        for (int i = 0; i < 4; ++i)
#pragma unroll
            for (int pp = 0; pp < 4; ++pp) { const bf16x8 aw = *(const LAS bf16x8*)(buf + (16 * i + col) * 272 + (32 * pp + 8 * quad) * 2);
                const bf16x8 aq = *(const LAS bf16x8*)(buf + GS_QS + (16 * i + col) * 272 + (32 * pp + 8 * quad) * 2);
                V[i] = MFMA16(aw, Sop[pp], V[i]); O[i] = MFMA16(aq, Sop[pp], O[i]); }
        bf16x8 Vop[2];
#pragma unroll
        for (int pp = 0; pp < 2; ++pp) { u32x4 w; w.x = pk2(V[2 * pp][0], V[2 * pp][1]); w.y = pk2(V[2 * pp][2], V[2 * pp][3]); w.z = pk2(V[2 * pp + 1][0], V[2 * pp + 1][1]); w.w = pk2(V[2 * pp + 1][2], V[2 * pp + 1][3]); Vop[pp] = __builtin_bit_cast(bf16x8, w); }
#pragma unroll
        for (int i = 0; i < 4; ++i)
#pragma unroll
            for (int pp = 0; pp < 2; ++pp) { const bf16x8 aa = *(const LAS bf16x8*)(buf + GS_A + (16 * i + col) * 144 + (32 * pp + 8 * quad) * 2); O[i] = MFMA16(aa, Vop[pp], O[i]); }
#pragma unroll
        for (int t = 0; t < 8; ++t) { S[t] = S[t] * eg;
#pragma unroll
            for (int pp = 0; pp < 2; ++pp) { const bf16x8 ak = *(const LAS bf16x8*)(buf + GS_KST + (16 * t + col) * 144 + (32 * pp + 8 * quad) * 2); S[t] = MFMA16(ak, Vop[pp], S[t]); } }
#pragma unroll
        for (int i = 0; i < 4; ++i)
#pragma unroll
            for (int jj = 0; jj < 4; ++jj) { float s = O[i][jj] * O[i][jj]; s += __shfl_xor(s, 1); s += __shfl_xor(s, 2); s += __shfl_xor(s, 4); s += __shfl_xor(s, 8);
                if (col == 0) part[wave * 64 + 16 * i + 4 * quad + jj] = s; }
        __syncthreads();
#pragma unroll
        for (int i = 0; i < 4; ++i)
#pragma unroll
            for (int jj = 0; jj < 4; ++jj) { const int c = 16 * i + 4 * quad + jj; float s = 0.f;
#pragma unroll
                for (int w = 0; w < 8; ++w) s += part[w * 64 + c];
                const float rstd = rsqrtf(s * (1.f / 128.f) + 1e-6f);
                const float gt = bf2f(graw[i * 4 + jj]);
                gdn_o[(orow0 + c) * 512 + h * 128 + n0 + col] = f2bf(O[i][jj] * rstd * nw * siluf_(gt)); }
        if (n + 1 < 32) GS_STORE((n + 1) & 1);
        __syncthreads();
    }
#undef GS_LOAD
#undef GS_STORE
}

constexpr int NA_KS = 0, NA_VT = 18432, NA_PS = 36864, NA_SELM = 70656, NA_UNI = 70912, NA_Q = 71168;
constexpr int NA_TILE = 9216;
struct NsaState { float m, l; f32x16 o0, o1; };
template <int MODE>
DI void nsa_tile(LAS unsigned char* lds, int bufi, const bf16x8 (&qf)[4], NsaState& st, int kbase, int t, int hi, int lane, float c1, float slope2, bool sel) {
    const LAS bf16_t* KS = (const LAS bf16_t*)(lds + NA_KS + bufi * NA_TILE);
    const LAS bf16_t* VT = (const LAS bf16_t*)(lds + NA_VT + bufi * NA_TILE);
    const int ql = lane & 31;
    f32x16 s0, s1;
#pragma unroll
    for (int r = 0; r < 16; ++r) { s0[r] = 0.f; s1[r] = 0.f; }
#pragma unroll
    for (int kk = 0; kk < 4; ++kk) {
        const bf16x8 a0 = *(const LAS bf16x8*)(KS + ql * 72 + 16 * kk + 8 * hi), a1 = *(const LAS bf16x8*)(KS + (32 + ql) * 72 + 16 * kk + 8 * hi);
        s0 = MFMA32(a0, qf[kk], s0); s1 = MFMA32(a1, qf[kk], s1);
    }
    float sl = slope2; asm volatile("" : "+v"(sl));
    const int dq = t - 4 * hi - kbase;
    const float base = -sl * (float)dq;
    float mx = -INFINITY;
#pragma unroll
    for (int r = 0; r < 16; ++r) {
        const int c0 = (r & 3) + 8 * (r >> 2), c1k = 32 + c0;
        bool v0 = sel && dq >= c0, v1 = sel && dq >= c1k;
        if (MODE == 1) { v0 = v0 && dq < 512 + c0; v1 = v1 && dq < 512 + c1k; }
        s0[r] = v0 ? (s0[r] * c1 + (base + sl * (float)c0)) : -INFINITY;
        s1[r] = v1 ? (s1[r] * c1 + (base + sl * (float)c1k)) : -INFINITY;
        mx = fmaxf(mx, fmaxf(s0[r], s1[r]));
    }
    mx = fmaxf(mx, __shfl_xor(mx, 32));
    const float mnew = fmaxf(st.m, mx);
    const float al = __builtin_amdgcn_exp2f(st.m - mnew);
    float rs = 0.f;
#pragma unroll
    for (int r = 0; r < 16; ++r) { s0[r] = __builtin_amdgcn_exp2f(s0[r] - mnew); s1[r] = __builtin_amdgcn_exp2f(s1[r] - mnew); rs += s0[r] + s1[r]; }
    rs += __shfl_xor(rs, 32);
    st.l = st.l * al + rs; st.m = mnew;
#pragma unroll
    for (int r = 0; r < 16; ++r) { st.o0[r] *= al; st.o1[r] *= al; }
#pragma unroll
    for (int sub = 0; sub < 2; ++sub)
#pragma unroll
        for (int u = 0; u < 2; ++u) {
            u32x4 pw;
            if (sub == 0) { pw.x = pk2(s0[8 * u], s0[8 * u + 1]); pw.y = pk2(s0[8 * u + 2], s0[8 * u + 3]); pw.z = pk2(s0[8 * u + 4], s0[8 * u + 5]); pw.w = pk2(s0[8 * u + 6], s0[8 * u + 7]); }
            else { pw.x = pk2(s1[8 * u], s1[8 * u + 1]); pw.y = pk2(s1[8 * u + 2], s1[8 * u + 3]); pw.z = pk2(s1[8 * u + 4], s1[8 * u + 5]); pw.w = pk2(s1[8 * u + 6], s1[8 * u + 7]); }
            const bf16x8 pb = __builtin_bit_cast(bf16x8, pw);
            const int kc = 32 * sub + 16 * u + 4 * hi;
            const s16x4 v00 = *(const LAS s16x4*)(VT + ql * 72 + kc), v01 = *(const LAS s16x4*)(VT + ql * 72 + kc + 8);
            const s16x4 v10 = *(const LAS s16x4*)(VT + (32 + ql) * 72 + kc), v11 = *(const LAS s16x4*)(VT + (32 + ql) * 72 + kc + 8);
            const bf16x8 va0 = {v00[0], v00[1], v00[2], v00[3], v01[0], v01[1], v01[2], v01[3]}, va1 = {v10[0], v10[1], v10[2], v10[3], v11[0], v11[1], v11[2], v11[3]};
            st.o0 = MFMA32(va0, pb, st.o0); st.o1 = MFMA32(va1, pb, st.o1);
        }
}
DI void nsa_ld(const bf16_t* hkv, int b, int g, int j, int kcol, u32x4& kr, u32x4& vr, int tid) {
    const int key = tid >> 3, d8 = (tid & 7) * 8; const bf16_t* src = hkv + (size_t)(b * SEQ + 64 * j + key) * 768 + g * 64 + d8;
    kr = *(const u32x4*)(src + kcol); vr = *(const u32x4*)(src + kcol + 128);
}
DI void nsa_st(LAS unsigned char* lds, int bufi, const u32x4& kr, const u32x4& vr, int tid) {
    const int key = tid >> 3, d8 = (tid & 7) * 8;
    *(LAS u32x4*)(lds + NA_KS + bufi * NA_TILE + (key * 72 + d8) * 2) = kr;
    LAS bf16_t* VT = (LAS bf16_t*)(lds + NA_VT + bufi * NA_TILE);
#pragma unroll
    for (int e = 0; e < 8; ++e) { const unsigned w = vr[e >> 1]; VT[(d8 + e) * 72 + key] = (unsigned short)((e & 1) ? (w >> 16) : (w & 0xffffu)); }
}
template <int MODE>
DI void nsa_branch(const Params& p, LAS unsigned char* lds, unsigned U, int b, int g, int kcol, const bf16x8 (&qf)[4], NsaState& st, int t, int hi, int lane, float c1, float slope2, unsigned myselm) {
    const bf16_t* hkv = (const bf16_t*)(p.ws + WS_HKV);
    const int tid = threadIdx.x;
    u32x4 kr, vr;
    unsigned rem = U;
    int j = __builtin_ctz(rem); rem &= rem - 1;
    nsa_ld(hkv, b, g, j, kcol, kr, vr, tid); nsa_st(lds, 0, kr, vr, tid);
    __syncthreads();
    int it = 0;
    for (;;) {
        const bool more = rem != 0u; int jn = 0;
        if (more) { jn = __builtin_ctz(rem); rem &= rem - 1; nsa_ld(hkv, b, g, jn, kcol, kr, vr, tid); }
        const bool sel = (MODE == 1) ? true : (((myselm >> j) & 1u) != 0u);
        if (__any(sel)) nsa_tile<MODE>(lds, it & 1, qf, st, 64 * j, t, hi, lane, c1, slope2, sel);
        if (more) nsa_st(lds, (it + 1) & 1, kr, vr, tid);
        __syncthreads();
        if (!more) break;
        j = jn; ++it;
    }
}
DI void nsa_unit(const Params& p, LAS unsigned char* lds, int unit, int wave, int lane) {
    const int tid = threadIdx.x;
    const int qb = 31 - (unit >> 4), bg = unit & 15, b = bg >> 1, g = bg & 1;
    const int t0 = qb * 64, ql = lane & 31, hi = lane >> 5, tl = 8 * wave + (ql >> 2), r = ql & 3, h = 4 * g + r, t = t0 + tl;
    const size_t rowg = (size_t)b * SEQ + t;
    const bf16_t* hq = (const bf16_t*)(p.ws + WS_HQ);
    const float* small = (const float*)(p.ws + WS_SMALL);
    bf16x8 qf[4];
#pragma unroll
    for (int kk = 0; kk < 4; ++kk) qf[kk] = *(const bf16x8*)(hq + rowg * 512 + h * 64 + 16 * kk + 8 * hi);
    const float slope2 = __builtin_amdgcn_exp2f(-(float)(h + 1)) * LOG2E, c1 = 0.125f * LOG2E;
    const float gc = sigmoidf_(small[rowg * 32 + h]), gs = sigmoidf_(small[rowg * 32 + 8 + h]), gw = sigmoidf_(small[rowg * 32 + 16 + h]);
    f32x16 oa0, oa1;
    LAS float* PS = (LAS float*)(lds + NA_PS);
    LAS unsigned* SELM = (LAS unsigned*)(lds + NA_SELM);
    LAS unsigned* UNI = (LAS unsigned*)(lds + NA_UNI);
    {
        const float* kc = (const float*)(p.ws + WS_KVC) + (size_t)((b * 2 + g) * 128) * 64;
        const float* vc = kc + (size_t)16 * 128 * 64;
        const int key = tid >> 2, d0 = (tid & 3) * 16, kb = key >> 6, kl = key & 63;
        f32x4 a[4], v[4];
#pragma unroll
        for (int e = 0; e < 4; ++e) { a[e] = *(const f32x4*)(kc + key * 64 + d0 + 4 * e); v[e] = *(const f32x4*)(vc + key * 64 + d0 + 4 * e); }
        *(LAS u32x4*)(lds + NA_KS + kb * NA_TILE + (kl * 72 + d0) * 2) = pack8(a[0], a[1]);
        *(LAS u32x4*)(lds + NA_KS + kb * NA_TILE + (kl * 72 + d0 + 8) * 2) = pack8(a[2], a[3]);
        LAS bf16_t* VT = (LAS bf16_t*)(lds + NA_VT + kb * NA_TILE);
#pragma unroll
        for (int e = 0; e < 16; ++e) VT[(d0 + e) * 72 + kl] = f2bf(v[e >> 2][e & 3]);
    }
    __syncthreads();
    {
        int ncmp = 4 * qb + 3; if (ncmp > 127) ncmp = 127;
        const int nsub = (ncmp + 31) >> 5;
        float m = -1.0e30f, l = 0.f;
        float slc = slope2; asm volatile("" : "+v"(slc));
        const int tq16 = t - 64 * hi - 31;
        const float basec = -slc * (float)tq16;
#pragma unroll
        for (int sub = 0; sub < 4; ++sub) {
            if (sub < nsub) {
                f32x16 sc;
#pragma unroll
                for (int i = 0; i < 16; ++i) sc[i] = 0.f;
                const LAS bf16_t* KS = (const LAS bf16_t*)(lds + NA_KS + (sub >> 1) * NA_TILE) + ((sub & 1) * 32 + ql) * 72 + 8 * hi;
#pragma unroll
                for (int kk = 0; kk < 4; ++kk) sc = MFMA32(*(const LAS bf16x8*)(KS + 16 * kk), qf[kk], sc);
                float mx = -INFINITY;
#pragma unroll
                for (int i = 0; i < 16; ++i) { const int cn = 16 * (32 * sub + (i & 3) + 8 * (i >> 2));
                    const bool val = (tq16 >= cn) && !(sub == 3 && i == 15 && hi == 1);
                    sc[i] = val ? (sc[i] * c1 + (basec + slc * (float)cn)) : -INFINITY; mx = fmaxf(mx, sc[i]); }
                mx = fmaxf(mx, __shfl_xor(mx, 32));
                const float mnew = fmaxf(m, mx);
                float rs = 0.f;
#pragma unroll
                for (int i = 0; i < 16; ++i) rs += __builtin_amdgcn_exp2f(sc[i] - mnew);
                rs += __shfl_xor(rs, 32);
                l = l * __builtin_amdgcn_exp2f(m - mnew) + rs; m = mnew;
            }
            asm volatile("" ::: "memory");
        }
        const float inv = (l > 0.f) ? 1.f / l : 0.f;
        f32x16 o0, o1;
#pragma unroll
        for (int i = 0; i < 16; ++i) { o0[i] = 0.f; o1[i] = 0.f; }
#pragma unroll
        for (int sub = 0; sub < 4; ++sub) {
            f32x16 sc;
#pragma unroll
            for (int i = 0; i < 16; ++i) sc[i] = 0.f;
            if (sub < nsub) {
                const LAS bf16_t* KS = (const LAS bf16_t*)(lds + NA_KS + (sub >> 1) * NA_TILE) + ((sub & 1) * 32 + ql) * 72 + 8 * hi;
#pragma unroll
                for (int kk = 0; kk < 4; ++kk) sc = MFMA32(*(const LAS bf16x8*)(KS + 16 * kk), qf[kk], sc);
#pragma unroll
                for (int i = 0; i < 16; ++i) { const int cn = 16 * (32 * sub + (i & 3) + 8 * (i >> 2));
                    const bool val = (tq16 >= cn) && !(sub == 3 && i == 15 && hi == 1);
                    sc[i] = val ? __builtin_amdgcn_exp2f((sc[i] * c1 + (basec + slc * (float)cn)) - m) * inv : 0.f; }
            }
#pragma unroll
            for (int q = 0; q < 4; ++q) { float gsum = (sc[4 * q] + sc[4 * q + 1]) + (sc[4 * q + 2] + sc[4 * q + 3]), lst = sc[4 * q + 3];
                gsum += __shfl_xor(gsum, 1); gsum += __shfl_xor(gsum, 2); lst += __shfl_xor(lst, 1); lst += __shfl_xor(lst, 2);
                if (r == 0) *(LAS f32x2*)(PS + tl * 66 + 2 * (8 * sub + 2 * q + hi)) = (f32x2){gsum, lst}; }
            if (sub < nsub) {
                const LAS bf16_t* VT = (const LAS bf16_t*)(lds + NA_VT + (sub >> 1) * NA_TILE);
#pragma unroll
                for (int u = 0; u < 2; ++u) {
                    u32x4 pw; pw.x = pk2(sc[8 * u], sc[8 * u + 1]); pw.y = pk2(sc[8 * u + 2], sc[8 * u + 3]); pw.z = pk2(sc[8 * u + 4], sc[8 * u + 5]); pw.w = pk2(sc[8 * u + 6], sc[8 * u + 7]);
                    const bf16x8 pb = __builtin_bit_cast(bf16x8, pw);
                    const int kc2 = (sub & 1) * 32 + 16 * u + 4 * hi;
                    const s16x4 v00 = *(const LAS s16x4*)(VT + ql * 72 + kc2), v01 = *(const LAS s16x4*)(VT + ql * 72 + kc2 + 8);
                    const s16x4 v10 = *(const LAS s16x4*)(VT + (32 + ql) * 72 + kc2), v11 = *(const LAS s16x4*)(VT + (32 + ql) * 72 + kc2 + 8);
                    const bf16x8 va0 = {v00[0], v00[1], v00[2], v00[3], v01[0], v01[1], v01[2], v01[3]}, va1 = {v10[0], v10[1], v10[2], v10[3], v11[0], v11[1], v11[2], v11[3]};
                    o0 = MFMA32(va0, pb, o0); o1 = MFMA32(va1, pb, o1);
                }
            }
            asm volatile("" ::: "memory");
        }
#pragma unroll
        for (int i = 0; i < 16; ++i) { oa0[i] = gc * o0[i]; oa1[i] = gc * o1[i]; }
    }
    __syncthreads();
    if (wave == 0) {
        const LAS float* pr = PS + lane * 66;
        float scv[32]; float lprev = 0.f;
#pragma unroll
        for (int j = 0; j < 32; ++j) { const f32x2 q2 = *(const LAS f32x2*)(pr + 2 * j); scv[j] = q2[0] + lprev; lprev = q2[1]; if ((j & 7) == 7) asm volatile("" ::: "memory"); }
#pragma unroll
        for (int j = 0; j < 32; ++j) { if (j == 0 || j == qb || j == qb - 1) scv[j] = 1.0e4f; else if (j > qb) scv[j] = -1.f; }
        unsigned msk = 0u;
#pragma unroll
        for (int k = 0; k < 8; ++k) { float best = -INFINITY; int bi = 0;
#pragma unroll
            for (int j = 0; j < 32; ++j) { const bool free_ = ((msk >> j) & 1u) == 0u; if (free_ && scv[j] > best) { best = scv[j]; bi = j; } }
            msk |= 1u << bi; }
        msk &= (2u << qb) - 1u;
        SELM[lane] = msk;
        unsigned un = msk;
#pragma unroll
        for (int o = 1; o < 64; o <<= 1) un |= __shfl_xor(un, o);
        if (lane == 0) UNI[0] = un;
    }
    __syncthreads();
    const unsigned myselm = SELM[tl]; const unsigned U = UNI[0];
    {
        NsaState st; st.m = -1.0e30f; st.l = 0.f;
#pragma unroll
        for (int i = 0; i < 16; ++i) { st.o0[i] = 0.f; st.o1[i] = 0.f; }
        nsa_branch<0>(p, lds, U, b, g, 256, qf, st, t, hi, lane, c1, slope2, myselm);
        const float f = (st.l > 0.f) ? gs / st.l : 0.f;
#pragma unroll
        for (int i = 0; i < 16; ++i) { oa0[i] += f * st.o0[i]; oa1[i] += f * st.o1[i]; }
    }
    {
        NsaState st; st.m = -1.0e30f; st.l = 0.f;
#pragma unroll
        for (int i = 0; i < 16; ++i) { st.o0[i] = 0.f; st.o1[i] = 0.f; }
        const int jlo = qb >= 8 ? qb - 8 : 0;
        const unsigned W = ((2u << qb) - 1u) & ~((1u << jlo) - 1u);
        nsa_branch<1>(p, lds, W, b, g, 512, qf, st, t, hi, lane, c1, slope2, 0u);
        const float f = (st.l > 0.f) ? gw / st.l : 0.f;
#pragma unroll
        for (int i = 0; i < 16; ++i) { oa0[i] += f * st.o0[i]; oa1[i] += f * st.o1[i]; }
    }
    bf16_t* no = (bf16_t*)(p.ws + WS_R32) + rowg * 512 + h * 64;
#pragma unroll
    for (int q4 = 0; q4 < 4; ++q4) {
        u32x2 w0; w0.x = pk2(oa0[4 * q4], oa0[4 * q4 + 1]); w0.y = pk2(oa0[4 * q4 + 2], oa0[4 * q4 + 3]);
        u32x2 w1; w1.x = pk2(oa1[4 * q4], oa1[4 * q4 + 1]); w1.y = pk2(oa1[4 * q4 + 2], oa1[4 * q4 + 3]);
        *(u32x2*)(no + 8 * q4 + 4 * hi) = w0; *(u32x2*)(no + 32 + 8 * q4 + 4 * hi) = w1;
    }
    __syncthreads();
}

DI void ln_rows(const float* zin, float* xout, bf16_t* xb, const float* gam, const float* bet, int gw, int NGW, int lane) {
    f32x4 gv[4], bv[4];
#pragma unroll
    for (int j = 0; j < 4; ++j) { gv[j] = *(const f32x4*)(gam + lane * 4 + 256 * j); bv[j] = *(const f32x4*)(bet + lane * 4 + 256 * j); }
    for (int m = gw; m < M; m += NGW) {
        const float* zr = zin + (size_t)m * DM + lane * 4;
        f32x4 v[4]; float s = 0.f;
#pragma unroll
        for (int j = 0; j < 4; ++j) { v[j] = *(const f32x4*)(zr + 256 * j); s += (v[j][0] + v[j][1]) + (v[j][2] + v[j][3]); }
        const float mean = wave_sum(s) * (1.f / DM); float s2 = 0.f;
#pragma unroll
        for (int j = 0; j < 4; ++j) { v[j] = v[j] - mean; s2 += (v[j][0] * v[j][0] + v[j][1] * v[j][1]) + (v[j][2] * v[j][2] + v[j][3] * v[j][3]); }
        const float rstd = rsqrtf(wave_sum(s2) * (1.f / DM) + 1e-5f);
#pragma unroll
        for (int j = 0; j < 4; ++j) { const f32x4 o = v[j] * rstd * gv[j] + bv[j];
            *(f32x4*)(xout + (size_t)m * DM + lane * 4 + 256 * j) = o;
            if (xb) { u32x2 w; w.x = pk2(o[0], o[1]); w.y = pk2(o[2], o[3]); *(u32x2*)(xb + (size_t)m * DM + lane * 4 + 256 * j) = w; } }
    }
}

DI void ffn_conv_act(const Params& p) {
    bf16_t* hup = (bf16_t*)(p.ws + WS_HUP); const bf16_t* halo = (const bf16_t*)(p.ws + WS_HALO);
    const int gtid = blockIdx.x * 512 + threadIdx.x, gsz = gridDim.x * 512;
    for (int it = gtid; it < 512 * 352; it += gsz) {
        const int rg = it / 352, c = (it - rg * 352) * 8, row0 = rg * 32;
        float wg[3][8], wv[3][8];
#pragma unroll
        for (int j = 0; j < 3; ++j) { const f32x4 a0 = *(const f32x4*)(p.ffn_conv + j * FF2 + c), a1 = *(const f32x4*)(p.ffn_conv + j * FF2 + c + 4), b0 = *(const f32x4*)(p.ffn_conv + j * FF2 + FF + c), b1 = *(const f32x4*)(p.ffn_conv + j * FF2 + FF + c + 4);
#pragma unroll
            for (int e = 0; e < 4; ++e) { wg[j][e] = a0[e]; wg[j][4 + e] = a1[e]; wv[j][e] = b0[e]; wv[j][4 + e] = b1[e]; } }
        float g2[8], g1[8], v2[8], v1[8];
        if ((rg & 63) != 0) {
            const u32x4 a = *(const u32x4*)(halo + ((size_t)(rg - 1) * 2 + 0) * FF2 + c), b = *(const u32x4*)(halo + ((size_t)(rg - 1) * 2 + 1) * FF2 + c);
            const u32x4 cc = *(const u32x4*)(halo + ((size_t)(rg - 1) * 2 + 0) * FF2 + FF + c), d = *(const u32x4*)(halo + ((size_t)(rg - 1) * 2 + 1) * FF2 + FF + c);
#pragma unroll
            for (int e = 0; e < 8; ++e) { g2[e] = (e & 1) ? __uint_as_float(a[e >> 1] & 0xffff0000u) : __uint_as_float(a[e >> 1] << 16); g1[e] = (e & 1) ? __uint_as_float(b[e >> 1] & 0xffff0000u) : __uint_as_float(b[e >> 1] << 16);
                v2[e] = (e & 1) ? __uint_as_float(cc[e >> 1] & 0xffff0000u) : __uint_as_float(cc[e >> 1] << 16); v1[e] = (e & 1) ? __uint_as_float(d[e >> 1] & 0xffff0000u) : __uint_as_float(d[e >> 1] << 16); }
        } else {
#pragma unroll
            for (int e = 0; e < 8; ++e) { g2[e] = 0.f; g1[e] = 0.f; v2[e] = 0.f; v1[e] = 0.f; }
        }
#pragma unroll 4
        for (int tl = 0; tl < 32; ++tl) {
            bf16_t* rp = hup + (size_t)(row0 + tl) * FF2 + c;
            const u32x4 a = *(const u32x4*)rp, b = *(const u32x4*)(rp + FF);
            float o[8];
#pragma unroll
            for (int e = 0; e < 8; ++e) { const float g0 = (e & 1) ? __uint_as_float(a[e >> 1] & 0xffff0000u) : __uint_as_float(a[e >> 1] << 16), v0 = (e & 1) ? __uint_as_float(b[e >> 1] & 0xffff0000u) : __uint_as_float(b[e >> 1] << 16);
                const float gg = wg[0][e] * g2[e] + wg[1][e] * g1[e] + wg[2][e] * g0, vv = wv[0][e] * v2[e] + wv[1][e] * v1[e] + wv[2][e] * v0;
                o[e] = siluf_(gg) * vv; g2[e] = g1[e]; g1[e] = g0; v2[e] = v1[e]; v1[e] = v0; }
            u32x4 w; w.x = pk2(o[0], o[1]); w.y = pk2(o[2], o[3]); w.z = pk2(o[4], o[5]); w.w = pk2(o[6], o[7]);
            *(u32x4*)rp = w;
        }
    }
}

constexpr int NPHASE = 11;
__global__ void __launch_bounds__(512, 2) fwd_kernel(Params p) {
    extern __shared__ __attribute__((aligned(16))) unsigned char lds_raw[];
    LAS unsigned char* lds = (LAS unsigned char*)lds_raw;
    cg::grid_group grid = cg::this_grid();
    const int tid = threadIdx.x, lane = tid & 63, wave = __builtin_amdgcn_readfirstlane(tid >> 6);
    const int G = gridDim.x, bx = blockIdx.x;
    const int lo = p.ph_lo, hi = p.ph_hi;
    unsigned* ctl = (unsigned*)(p.ws + WS_CTL);
#ifndef PHMASK
#define PHMASK 0xffff
#endif
#define IN(k) (((PHMASK >> (k)) & 1) && lo <= (k) && (k) < hi)
#define SEAM(k) do { if (IN(k) && IN((k) + 1)) grid.sync(); } while (0)
    bf16_t* const r32 = (bf16_t*)(p.ws + WS_R32);
    if (IN(0)) { p0_prologue(p, lds, wave, lane); }
    SEAM(0);
    if (IN(1)) {
        pg8::Gemm g{r32, (const bf16_t*)(p.ws + WS_WIN), M, NIN, DM, DM}; pg8::StaticOrder S; S.init(M, NIN, G, bx);
        EpiH E{(bf16_t*)(p.ws + WS_HQ), (bf16_t*)(p.ws + WS_HKV), (bf16_t*)(p.ws + WS_HG), (bf16_t*)(p.ws + WS_HGG), (bf16_t*)(p.ws + WS_HM), (float*)(p.ws + WS_SMALL)};
        pg8::gemm_phase<EpiH>(lds, g, S, E);
    }
    SEAM(1);
    if (IN(2)) {
        for (int task = bx; task < 256; task += G) cmp_task(p, lds, task, wave, lane);
        for (int task = bx; task < 1024; task += G) gdn_prep_task(p, lds, task, wave, lane);
    }
    SEAM(2);
    if (IN(3)) {
        if (bx < 32) gdn_scan(p, lds, bx, wave, lane);
        LAS unsigned* qslot = (LAS unsigned*)(lds + NA_Q);
        for (;;) {
            __syncthreads();
            if (tid == 0) qslot[0] = atomicAdd(ctl, 1u);
            __syncthreads();
            const unsigned unit = qslot[0];
            if (unit >= 512u) break;
            nsa_unit(p, lds, (int)unit, wave, lane);
        }
    }
    SEAM(3);
    if (IN(4)) {
        bf16_t* mix = (bf16_t*)(p.ws + WS_MIX);
        { pg8::Gemm g{r32, (const bf16_t*)(p.ws + WS_WNSA), M, DM, 512, 512}; pg8::StaticOrder S; S.init(M, DM, G, bx);
          EpiGate<0> E{(const bf16_t*)(p.ws + WS_HM), mix}; pg8::gemm_phase<EpiGate<0>>(lds, g, S, E); }
        { pg8::Gemm g{r32 + (size_t)M * 512, (const bf16_t*)(p.ws + WS_WGDN), M, DM, 512, 512}; pg8::StaticOrder S; S.init(M, DM, G, bx);
          EpiGate<1> E{(const bf16_t*)(p.ws + WS_HM), mix}; pg8::gemm_phase<EpiGate<1>>(lds, g, S, E); }
    }
    SEAM(4);
    if (IN(5)) {
        pg8::Gemm g{(const bf16_t*)(p.ws + WS_MIX), (const bf16_t*)(p.ws + WS_WO), M, DM, DM, DM}; pg8::StaticOrder S; S.init(M, DM, G, bx);
        EpiZ E{p.x, p.out}; pg8::gemm_phase<EpiZ>(lds, g, S, E);
    }
    SEAM(5);
    if (IN(6)) { ln_rows(p.out, p.out, r32, p.ln1g, p.ln1b, bx * 8 + wave, G * 8, lane); }
    SEAM(6);
    if (IN(7)) {
        pg8::Gemm g{r32, (const bf16_t*)(p.ws + WS_WUP), M, FF2, DM, DM}; pg8::StaticOrder S; S.init(M, FF2, G, bx);
        EpiUp E{(bf16_t*)(p.ws + WS_HUP), (bf16_t*)(p.ws + WS_HALO)}; pg8::gemm_phase<EpiUp>(lds, g, S, E);
    }
    SEAM(7);
    if (IN(8)) { ffn_conv_act(p); }
    SEAM(8);
    if (IN(9)) {
        pg8::Gemm g{(const bf16_t*)(p.ws + WS_HUP), (const bf16_t*)(p.ws + WS_WDN), M, DM, FF, FF2}; pg8::StaticOrder S; S.init(M, DM, G, bx);
        EpiZ E{p.out, p.out}; pg8::gemm_phase<EpiZ>(lds, g, S, E);
    }
    SEAM(9);
    if (IN(10)) { ln_rows(p.out, p.out, nullptr, p.ln2g, p.ln2b, bx * 8 + wave, G * 8, lane); }
#undef IN
#undef SEAM
}

#ifndef N_LAUNCH_MODE
#define N_LAUNCH_MODE 1
#endif
extern "C" void kernel_launch(void* const* d_in, const int* in_sizes, int n_in, void* d_out, int out_size, void* d_ws, size_t ws_size, hipStream_t stream) {
    static int grid = 0;
    if (grid == 0) {
        if (n_in != 19 || out_size != M * DM || ws_size < WS_END) { fprintf(stderr, "kernel_launch: unexpected shapes (n_in %d out %d ws %zu)\n", n_in, out_size, ws_size); grid = -1; return; }
        int dev = 0, cus = 0, per_cu = 0;
        (void)hipGetDevice(&dev);
        (void)hipDeviceGetAttribute(&cus, hipDeviceAttributeMultiprocessorCount, dev);
        (void)hipFuncSetAttribute((const void*)fwd_kernel, hipFuncAttributeMaxDynamicSharedMemorySize, LDS_BYTES);
        (void)hipOccupancyMaxActiveBlocksPerMultiprocessor(&per_cu, (const void*)fwd_kernel, 512, LDS_BYTES);
        if (per_cu < 1) per_cu = 1;
        grid = cus * per_cu;
        fprintf(stderr, "kernel_launch: grid %d (cus %d x %d)\n", grid, cus, per_cu);
    }
    if (grid < 0) return;
    (void)hipMemsetAsync((char*)d_ws + WS_CTL, 0, 4096, stream);
    Params p{};
    const float** pp = (const float**)&p;
    for (int i = 0; i < 19; ++i) pp[i] = (const float*)d_in[i];
    p.out = (float*)d_out; p.ws = (unsigned char*)d_ws;
#if N_LAUNCH_MODE == 1
    p.ph_lo = 0; p.ph_hi = NPHASE;
    void* args[] = {&p};
    hipError_t e = hipLaunchCooperativeKernel((const void*)fwd_kernel, dim3(grid), dim3(512), args, LDS_BYTES, stream);
    if (e != hipSuccess) fprintf(stderr, "cooperative launch failed: %s (grid %d)\n", hipGetErrorString(e), grid);
#else
    for (int ph = 0; ph < NPHASE; ++ph) { p.ph_lo = ph; p.ph_hi = ph + 1; hipLaunchKernelGGL(fwd_kernel, dim3(grid), dim3(512), LDS_BYTES, stream, p); }
#endif
}
```

```cpp
#include <hip/hip_runtime.h>
#include <hip/hip_cooperative_groups.h>
#include <cstdio>
#include <cstdint>
namespace cg = cooperative_groups;

#define LAS __attribute__((address_space(3)))
#define DI __device__ __forceinline__
typedef unsigned short bf16_t;
typedef short bf16x8 __attribute__((ext_vector_type(8)));
typedef short s16x4 __attribute__((ext_vector_type(4)));
typedef float f32x4 __attribute__((ext_vector_type(4)));
typedef float f32x16 __attribute__((ext_vector_type(16)));
typedef float f32x2 __attribute__((ext_vector_type(2)));
typedef unsigned u32x4 __attribute__((ext_vector_type(4)));
typedef unsigned u32x2 __attribute__((ext_vector_type(2)));
typedef __bf16 bf16x2_t __attribute__((ext_vector_type(2)));

constexpr int SEQ = 2048, BATCH = 8, DM = 1024, M = BATCH * SEQ;
constexpr int NIN = 5632;
constexpr int FF = 2816, FF2 = 5632;
constexpr float ALPHA = 1.189207115002721f;
constexpr float LOG2E = 1.4426950408889634f;
constexpr int LDS_BYTES = 147456;
constexpr size_t MiB = 1u << 20;
constexpr size_t WS_CTL = 0;
constexpr size_t WS_WIN = 1 * MiB, WS_WUP = 12 * MiB, WS_WDN = 23 * MiB, WS_WO = 29 * MiB, WS_WNSA = 31 * MiB, WS_WGDN = 32 * MiB;
constexpr size_t WS_W1C = 33 * MiB;
constexpr size_t WS_EGL = 33 * MiB + 512 * 1024;
constexpr size_t WS_KVC = 34 * MiB;
constexpr size_t WS_SMALL = 35 * MiB;
constexpr size_t WS_R32 = 37 * MiB;
constexpr size_t WS_H = 69 * MiB;
constexpr size_t WS_HQ = WS_H, WS_HKV = WS_H + 16 * MiB, WS_HG = WS_H + 40 * MiB, WS_HGG = WS_H + 88 * MiB, WS_HM = WS_H + 104 * MiB;
constexpr size_t WS_APERM = WS_H + 168 * MiB;
constexpr size_t WS_MIX = WS_HG;
constexpr size_t WS_ACT = WS_H;
constexpr size_t WS_END = 256 * MiB;
constexpr size_t DO_WNEG = 0, DO_QS = 8u << 20, DO_KST = 16u << 20, DO_UT = 24u << 20;

DI float bf2f(unsigned short u) { return __uint_as_float((unsigned)u << 16); }
DI unsigned pk2(float lo, float hi) { f32x2 v = {lo, hi}; bf16x2_t b = __builtin_convertvector(v, bf16x2_t); return __builtin_bit_cast(unsigned, b); }
DI unsigned short f2bf(float f) { return (unsigned short)(pk2(f, 0.f) & 0xffffu); }
DI float sigmoidf_(float x) { return 1.f / (1.f + __expf(-x)); }
DI float siluf_(float x) { return x / (1.f + __expf(-x)); }
DI float wave_sum(float v) {
#pragma unroll
    for (int o = 1; o < 64; o <<= 1) v += __shfl_xor(v, o);
    return v;
}
DI int crow(int r, int hi) { return (r & 3) + 8 * (r >> 2) + 4 * hi; }
DI int posperm(int x) { return (x & ~31) + ((x >> 2) & 3) * 8 + ((x >> 4) & 1) * 4 + (x & 3); }
#define MFMA16(a, b, c) __builtin_amdgcn_mfma_f32_16x16x32_bf16((a), (b), (c), 0, 0, 0)
#define MFMA32(a, b, c) __builtin_amdgcn_mfma_f32_32x32x16_bf16((a), (b), (c), 0, 0, 0)

namespace pg8 {
constexpr int BM = 256, BK = 64, HALF = 128, HTB = HALF * BK * 2, STAGE_BYTES = 8 * HTB, NXCD = 8, WGM = 8;
__host__ __device__ __forceinline__ int lds_byte(int r, int c) { const int st = (r >> 4) * 2 + (c >> 5), rr = r & 15, cc = c & 31, ob = rr * 64 + cc * 2; return st * 1024 + (ob ^ (((ob >> 9) & 1) << 5)); }
__host__ __device__ __forceinline__ void stage_rc(int b, int& R, int& C) { const int st = b / 1024, sb = b % 1024, swz = sb ^ (((sb >> 9) & 1) << 5); R = (st >> 1) * 16 + swz / 64; C = (st & 1) * 32 + (swz % 64) / 2; }
__host__ __device__ __forceinline__ int perm32(int rho) { const int n = rho >> 4, i = rho & 15; return 8 * (i >> 2) + 4 * n + (i & 3); }
struct Unit { int pm, pn; };
struct Gemm { const bf16_t* A; const bf16_t* Bt; int M, N, K, lda, mrow0, mstep; };
struct StaticOrder {
    int nM, nN, nwg, G, c;
    __host__ __device__ void init(int M_, int N_, int G_, int c_) { nM = M_ / BM; nN = N_ / BM; nwg = nM * nN; G = G_; c = c_; }
    __host__ __device__ void init2(int nM_, int nN_, int G_, int c_) { nM = nM_; nN = nN_; nwg = nM * nN; G = G_; c = c_; }
    __host__ __device__ bool next(int i, Unit& u) const {
        const long L = (long)i * G + c; if (L >= nwg) return false;
        int wgid = (int)L; { const int q = nwg / NXCD, r = nwg % NXCD, xcd = wgid % NXCD, off = wgid / NXCD; wgid = (xcd < r ? xcd * (q + 1) : r * (q + 1) + (xcd - r) * q) + off; }
        const int nig = WGM * nN, gid = wgid / nig, fm = gid * WGM, gsz = (nM - fm) < WGM ? (nM - fm) : WGM;
        u.pm = fm + ((wgid % nig) % gsz); u.pn = (wgid % nig) / gsz; return true;
    }
};
template <class Epi>
__device__ __forceinline__ void gemm_phase(LAS unsigned char* lds, const Gemm g, const StaticOrder& S, const Epi& E) {
    const int tid = threadIdx.x, wid = __builtin_amdgcn_readfirstlane(tid >> 6), lane = tid & 63, wr = wid >> 2, wc = wid & 3, fr = lane & 15, fq = lane >> 4;
    const int K = g.K, nt = K / BK, lda = g.lda;
    unsigned voffA[2], voffB[2];
#pragma unroll
    for (int i = 0; i < 2; ++i) { int R, C; stage_rc(tid * 16 + i * 8192, R, C); const int Rb = Epi::PERM ? ((R & ~31) + perm32(R & 31)) : R;
        voffA[i] = (unsigned)(R * lda + C) * 2u; voffB[i] = (unsigned)(Rb * K + C) * 2u; }
    const size_t kstep = (size_t)(BK * 2);
    const size_t hstepA = (size_t)HALF * lda * 2, hstepB = (size_t)HALF * K * 2;
    const size_t tstepA = (size_t)g.mstep * lda * 2, tstepB = 2 * hstepB;
    const char* const Abase = (const char*)g.A + (ptrdiff_t)g.mrow0 * lda * 2;
    const unsigned ldsw = (unsigned)wid * 1024u;
    const int aoff = lds_byte(wr * 64 + fr, fq * 8), boff = lds_byte(wc * 32 + fr, fq * 8);
#define PG8_SA(b, h) (((b) * 2 + (h)) * HTB)
#define PG8_SB(b, h) ((4 + (b) * 2 + (h)) * HTB)
#define PG8_STAGE(bufoff, gbase, voff) do { _Pragma("unroll") for (int _i = 0; _i < 2; ++_i) \
        __builtin_amdgcn_global_load_lds((const unsigned*)((const char*)(gbase) + (voff)[_i]), (LAS unsigned*)(lds + (bufoff) + ldsw + _i * 8192), 16, 0, 0); } while (0)
#define PG8_LDA(dst, b, h) do { _Pragma("unroll") for (int m = 0; m < 4; ++m) _Pragma("unroll") for (int k = 0; k < 2; ++k) dst[m][k] = *(const LAS bf16x8*)(lds + PG8_SA(b, h) + aoff + m * 2048 + k * 1024); } while (0)
#define PG8_LDB(dst, b, h) do { _Pragma("unroll") for (int n = 0; n < 2; ++n) _Pragma("unroll") for (int k = 0; k < 2; ++k) dst[n][k] = *(const LAS bf16x8*)(lds + PG8_SB(b, h) + boff + n * 2048 + k * 1024); } while (0)
#define PG8_MMA(ai, bj, At, Bt) do { __builtin_amdgcn_s_setprio(1); _Pragma("unroll") for (int m = 0; m < 4; ++m) _Pragma("unroll") for (int n = 0; n < 2; ++n) _Pragma("unroll") for (int k = 0; k < 2; ++k) \
        acc[ai][bj][m][n] = __builtin_amdgcn_mfma_f32_16x16x32_bf16(Bt[n][k], At[m][k], acc[ai][bj][m][n], 0, 0, 0); __builtin_amdgcn_s_setprio(0); } while (0)
#define PG8_WAIT_V(n) asm volatile("s_waitcnt vmcnt(" #n ")" ::: "memory")
#define PG8_WAIT_L(n) asm volatile("s_waitcnt lgkmcnt(" #n ")" ::: "memory")
#define PG8_BAR __builtin_amdgcn_s_barrier()
#define PG8_SCHED __builtin_amdgcn_sched_barrier(0)
    Unit cur, nxt; int ui = 0;
    if (!S.next(0, cur)) return;
    f32x4 acc[2][2][4][2];
#pragma unroll
    for (int a = 0; a < 2; ++a)
#pragma unroll
        for (int b = 0; b < 2; ++b)
#pragma unroll
            for (int m = 0; m < 4; ++m)
#pragma unroll
                for (int n = 0; n < 2; ++n) acc[a][b][m][n] = (f32x4){0.f, 0.f, 0.f, 0.f};
    bf16x8 At[4][2], B0[2][2], B1[2][2];
    const char* cA = Abase + (size_t)cur.pm * tstepA; const char* cB = (const char*)g.Bt + (size_t)cur.pn * tstepB;
    PG8_STAGE(PG8_SB(0, 0), cB, voffB); PG8_STAGE(PG8_SB(0, 1), cB + hstepB, voffB); PG8_STAGE(PG8_SA(0, 0), cA, voffA); PG8_STAGE(PG8_SA(0, 1), cA + hstepA, voffA);
    if (wr == 1) PG8_BAR;
    PG8_WAIT_V(2); PG8_BAR;
    PG8_STAGE(PG8_SB(1, 0), cB + kstep, voffB); PG8_STAGE(PG8_SA(1, 0), cA + kstep, voffA); PG8_STAGE(PG8_SB(1, 1), cB + hstepB + kstep, voffB);
    PG8_WAIT_V(6); PG8_BAR;
    for (;;) {
        const bool has_next = S.next(ui + 1, nxt);
        const char* nA = has_next ? Abase + (size_t)nxt.pm * tstepA : cA; const char* nB = has_next ? (const char*)g.Bt + (size_t)nxt.pn * tstepB : cB;
        for (int t = 0; t < nt; t += 2) {
            const bool last = (t == nt - 2);
            const char* a1 = cA + (size_t)(t + 1) * kstep;
            const char* a2 = last ? nA : cA + (size_t)(t + 2) * kstep; const char* b2 = last ? nB : cB + (size_t)(t + 2) * kstep;
            const char* a3 = a2 + kstep; const char* b3 = b2 + kstep;
            PG8_LDB(B0, 0, 0); PG8_LDB(B1, 0, 1); PG8_SCHED; PG8_LDA(At, 0, 0); PG8_STAGE(PG8_SA(1, 1), a1 + hstepA, voffA);
            PG8_WAIT_V(8); PG8_WAIT_L(0); PG8_BAR; PG8_MMA(0, 0, At, B0); PG8_MMA(0, 1, At, B1); PG8_BAR; PG8_SCHED;
            PG8_LDA(At, 0, 1); PG8_STAGE(PG8_SB(0, 0), b2, voffB); PG8_STAGE(PG8_SB(0, 1), b2 + hstepB, voffB); PG8_STAGE(PG8_SA(0, 0), a2, voffA);
            PG8_WAIT_V(8); PG8_WAIT_L(0); PG8_BAR; PG8_MMA(1, 0, At, B0); PG8_MMA(1, 1, At, B1); PG8_BAR; PG8_SCHED;
            PG8_LDB(B0, 1, 0); PG8_LDB(B1, 1, 1); PG8_SCHED; PG8_LDA(At, 1, 0); PG8_STAGE(PG8_SA(0, 1), a2 + hstepA, voffA);
            PG8_WAIT_V(8); PG8_WAIT_L(0); PG8_BAR; PG8_MMA(0, 0, At, B0); PG8_MMA(0, 1, At, B1); PG8_BAR; PG8_SCHED;
            PG8_LDA(At, 1, 1); PG8_STAGE(PG8_SB(1, 0), b3, voffB); PG8_STAGE(PG8_SB(1, 1), b3 + hstepB, voffB); PG8_STAGE(PG8_SA(1, 0), a3, voffA);
            PG8_WAIT_V(8); PG8_WAIT_L(0); PG8_BAR; PG8_MMA(1, 0, At, B0); PG8_MMA(1, 1, At, B1); PG8_BAR; PG8_SCHED;
        }
        if (wr == 0) PG8_BAR;
        E(acc, cur, wr, wc, fr, fq);
        if (!has_next) break;
#pragma unroll
        for (int a = 0; a < 2; ++a)
#pragma unroll
            for (int b = 0; b < 2; ++b)
#pragma unroll
                for (int m = 0; m < 4; ++m)
#pragma unroll
                    for (int n = 0; n < 2; ++n) acc[a][b][m][n] = (f32x4){0.f, 0.f, 0.f, 0.f};
        cur = nxt; cA = nA; cB = nB; ++ui;
        if (wr == 1) PG8_BAR;
    }
    PG8_WAIT_V(0);
    PG8_BAR;
#undef PG8_SA
#undef PG8_SB
#undef PG8_STAGE
#undef PG8_LDA
#undef PG8_LDB
#undef PG8_MMA
#undef PG8_WAIT_V
#undef PG8_WAIT_L
#undef PG8_BAR
#undef PG8_SCHED
}
}
using pg8::Unit;
typedef f32x4 AccT[2][2][4][2];

DI u32x4 pack8(const f32x4& v0, const f32x4& v1) { u32x4 w; w.x = pk2(v0[0], v0[1]); w.y = pk2(v0[2], v0[3]); w.z = pk2(v1[0], v1[1]); w.w = pk2(v1[2], v1[3]); return w; }
struct EpiH {
    static constexpr bool PERM = true;
    bf16_t *hq, *hkv, *hg, *hgg, *hm; float* small;
    DI void operator()(const AccT& acc, const Unit& u, int wr, int wc, int fr, int fq) const {
        const int pn = u.pn; const int row0 = u.pm * 256 + wr * 64 + fr;
        if (pn == 21) {
            if (wc == 0) {
#pragma unroll
                for (int ai = 0; ai < 2; ++ai)
#pragma unroll
                    for (int m = 0; m < 4; ++m) { float* rp = small + (size_t)(row0 + ai * 128 + m * 16) * 32 + 8 * fq;
                        *(f32x4*)rp = acc[ai][0][m][0]; *(f32x4*)(rp + 4) = acc[ai][0][m][1]; }
            }
            return;
        }
        bf16_t* base; int ldc, ct;
        if (pn < 2) { base = hq; ldc = 512; ct = pn; } else if (pn < 5) { base = hkv; ldc = 768; ct = pn - 2; } else if (pn < 11) { base = hg; ldc = 1536; ct = pn - 5; }
        else if (pn < 13) { base = hgg; ldc = 512; ct = pn - 11; } else { base = hm; ldc = 2048; ct = pn - 13; }
        const int col0 = ct * 256 + wc * 32 + 8 * fq;
#pragma unroll
        for (int ai = 0; ai < 2; ++ai)
#pragma unroll
            for (int m = 0; m < 4; ++m) { bf16_t* rowp = base + (size_t)(row0 + ai * 128 + m * 16) * ldc + col0;
#pragma unroll
                for (int bj = 0; bj < 2; ++bj) *(u32x4*)(rowp + bj * 128) = pack8(acc[ai][bj][m][0], acc[ai][bj][m][1]); }
    }
};
template <int MODE> struct EpiGate {
    static constexpr bool PERM = true;
    const bf16_t* hm; bf16_t* mix;
    DI void operator()(const AccT& acc, const Unit& u, int wr, int wc, int fr, int fq) const {
        const int row0 = u.pm * 256 + wr * 64 + fr, col0 = u.pn * 256 + wc * 32 + 8 * fq;
#pragma unroll
        for (int ai = 0; ai < 2; ++ai)
#pragma unroll
            for (int m = 0; m < 4; ++m) { const size_t row = (size_t)(row0 + ai * 128 + m * 16);
#pragma unroll
                for (int bj = 0; bj < 2; ++bj) { const int col = col0 + bj * 128;
                    const u32x4 gv = *(const u32x4*)(hm + row * 2048 + MODE * 1024 + col);
                    u32x4 old = {0u, 0u, 0u, 0u}; if (MODE == 1) old = *(const u32x4*)(mix + row * 1024 + col);
                    float o[8];
#pragma unroll
                    for (int e = 0; e < 8; ++e) { const unsigned gw = gv[e >> 1], ow = old[e >> 1];
                        const float gg = (e & 1) ? __uint_as_float(gw & 0xffff0000u) : __uint_as_float(gw << 16);
                        const float oo = (e & 1) ? __uint_as_float(ow & 0xffff0000u) : __uint_as_float(ow << 16);
                        const float a = (e < 4) ? acc[ai][bj][m][0][e & 3] : acc[ai][bj][m][1][e & 3];
                        o[e] = sigmoidf_(gg) * a + (MODE == 1 ? oo : 0.f); }
                    u32x4 w; w.x = pk2(o[0], o[1]); w.y = pk2(o[2], o[3]); w.z = pk2(o[4], o[5]); w.w = pk2(o[6], o[7]);
                    *(u32x4*)(mix + row * 1024 + col) = w; } }
    }
};
struct EpiZ {
    static constexpr bool PERM = false;
    const float* base; float* out;
    DI void operator()(const AccT& acc, const Unit& u, int wr, int wc, int fr, int fq) const {
        const int row0 = u.pm * 256 + wr * 64 + fr, col0 = u.pn * 256 + wc * 32 + 4 * fq;
#pragma unroll
        for (int ai = 0; ai < 2; ++ai)
#pragma unroll
            for (int m = 0; m < 4; ++m) { const size_t off = (size_t)(row0 + ai * 128 + m * 16) * 1024 + col0;
#pragma unroll
                for (int bj = 0; bj < 2; ++bj)
#pragma unroll
                    for (int n = 0; n < 2; ++n) { const f32x4 bs = *(const f32x4*)(base + off + bj * 128 + n * 16); *(f32x4*)(out + off + bj * 128 + n * 16) = bs * ALPHA + acc[ai][bj][m][n]; } }
    }
};
DI float dpp_shr1(float oldv, float v) { return __int_as_float(__builtin_amdgcn_update_dpp(__float_as_int(oldv), __float_as_int(v), 0x111, 0xf, 0xf, false)); }
DI float dpp_shr2(float oldv, float v) { return __int_as_float(__builtin_amdgcn_update_dpp(__float_as_int(oldv), __float_as_int(v), 0x112, 0xf, 0xf, false)); }
DI float dpp_ror1(float v) { return __int_as_float(__builtin_amdgcn_update_dpp(0, __float_as_int(v), 0x121, 0xf, 0xf, false)); }
DI float dpp_ror2(float v) { return __int_as_float(__builtin_amdgcn_update_dpp(0, __float_as_int(v), 0x122, 0xf, 0xf, false)); }
struct EpiUpAct {
    static constexpr bool PERM = true;
    bf16_t* act; const float* cw; LAS float* xl;
    DI void operator()(const AccT& acc, const Unit& u, int wr, int wc, int fr, int fq) const {
        const int wave = wr * 4 + wc;
        if (fr >= 14) {
#pragma unroll
            for (int ai = 0; ai < 2; ++ai)
#pragma unroll
                for (int bj = 0; bj < 2; ++bj)
#pragma unroll
                    for (int n = 0; n < 2; ++n) *(LAS f32x4*)(xl + ((wave * 2 + ai) * 2 + (fr - 14)) * 64 + bj * 32 + fq * 8 + n * 4) = acc[ai][bj][3][n];
        }
        asm volatile("s_waitcnt lgkmcnt(0)" ::: "memory"); __builtin_amdgcn_s_barrier(); asm volatile("" ::: "memory");
        const int colg = 128 * u.pn + 32 * wc + 8 * fq;
#pragma unroll
        for (int n = 0; n < 2; ++n) {
            f32x4 wg[3], wv[3];
#pragma unroll
            for (int j = 0; j < 3; ++j) { wg[j] = *(const f32x4*)(cw + j * FF2 + colg + 4 * n); wv[j] = *(const f32x4*)(cw + j * FF2 + FF + colg + 4 * n); }
#pragma unroll
            for (int ai = 0; ai < 2; ++ai) {
                const bool hasprev = !(ai == 0 && wr == 0);
                const int pw = (wr == 1) ? (wave - 4) : (wave + 4), pai = (wr == 1) ? ai : (ai - 1);
#pragma unroll
                for (int m = 0; m < 4; ++m) {
                    const int r = 128 * ai + 64 * wr + 16 * m + fr; const int grow = 254 * u.pm - 2 + r; const int sp = grow & 2047;
                    f32x4 o1g, o2g, o1v, o2v;
                    if (m == 0) {
                        if (hasprev) {
                            const LAS float* b15 = xl + ((pw * 2 + pai) * 2 + 1) * 64 + fq * 8 + n * 4;
                            const LAS float* b2 = xl + ((pw * 2 + pai) * 2 + (fr == 0 ? 0 : 1)) * 64 + fq * 8 + n * 4;
                            o1g = *(const LAS f32x4*)b15; o1v = *(const LAS f32x4*)(b15 + 32); o2g = *(const LAS f32x4*)b2; o2v = *(const LAS f32x4*)(b2 + 32);
                        } else { o1g = (f32x4){0.f, 0.f, 0.f, 0.f}; o1v = o1g; o2g = o1g; o2v = o1g; }
                    } else {
#pragma unroll
                        for (int e = 0; e < 4; ++e) { o1g[e] = dpp_ror1(acc[ai][0][m - 1][n][e]); o2g[e] = dpp_ror2(acc[ai][0][m - 1][n][e]); o1v[e] = dpp_ror1(acc[ai][1][m - 1][n][e]); o2v[e] = dpp_ror2(acc[ai][1][m - 1][n][e]); }
                    }
                    float o[4];
#pragma unroll
                    for (int e = 0; e < 4; ++e) {
                        const float g0 = acc[ai][0][m][n][e], v0 = acc[ai][1][m][n][e];
                        float g1 = dpp_shr1(o1g[e], g0), g2 = dpp_shr2(o2g[e], g0), v1 = dpp_shr1(o1v[e], v0), v2 = dpp_shr2(o2v[e], v0);
                        if (sp < 1) { g1 = 0.f; v1 = 0.f; }
                        if (sp < 2) { g2 = 0.f; v2 = 0.f; }
                        const float gg = wg[0][e] * g2 + wg[1][e] * g1 + wg[2][e] * g0, vv = wv[0][e] * v2 + wv[1][e] * v1 + wv[2][e] * v0;
                        o[e] = siluf_(gg) * vv;
                    }
                    if (r >= 2 && grow < M) { u32x2 w; w.x = pk2(o[0], o[1]); w.y = pk2(o[2], o[3]); *(u32x2*)(act + (size_t)grow * FF + colg + 4 * n) = w; }
                }
            }
        }
    }
};

struct Params {
    const float *x, *w_in, *cmp_pos, *cmp_w1, *cmp_w2, *w_nsa, *gdn_conv, *a_log, *dt_bias, *norm_w, *w_gdn, *w_o, *ln1g, *ln1b, *w_up, *ffn_conv, *w_dn, *ln2g, *ln2b;
    float* out; unsigned char* ws; int ph_lo, ph_hi, rep, pad;
};

DI void tr_item(const float* W, int K, int Nsrc, int c0, int width, bf16_t* WT, int r0, LAS float* scr, int item, int lane) {
    const int nblk = (width + 31) >> 5, kb = item / nblk, nb = item - kb * nblk, k0 = 64 * kb, n0 = 32 * nb;
    const bool cin = (n0 + (lane & 31)) < width;
#pragma unroll 8
    for (int i = 0; i < 32; ++i) { const int kk = 2 * i + (lane >> 5); scr[kk * 33 + (lane & 31)] = cin ? W[(size_t)(k0 + kk) * Nsrc + c0 + n0 + (lane & 31)] : 0.f; }
    asm volatile("s_waitcnt lgkmcnt(0)" ::: "memory");
    const int c = lane & 7;
#pragma unroll
    for (int j = 0; j < 4; ++j) { const int n = (lane >> 3) + 8 * j; const LAS float* s = scr + (8 * c) * 33 + n;
        u32x4 o; o.x = pk2(s[0 * 33], s[1 * 33]); o.y = pk2(s[2 * 33], s[3 * 33]); o.z = pk2(s[4 * 33], s[5 * 33]); o.w = pk2(s[6 * 33], s[7 * 33]);
        if (n0 + n < width) *(u32x4*)(WT + (size_t)(r0 + n0 + n) * K + k0 + 8 * c) = o; }
    asm volatile("s_waitcnt lgkmcnt(0)" ::: "memory");
}
DI void p0_prologue(const Params& p, LAS unsigned char* lds, int wave, int lane) {
    LAS float* scr = (LAS float*)(lds + wave * 16384);
    const int gw = blockIdx.x * 8 + wave, NGW = gridDim.x * 8;
    bf16_t* win = (bf16_t*)(p.ws + WS_WIN);
    constexpr int TOTAL = 16 * 171 + 16 * 176 + 44 * 32 + 16 * 32 + 8 * 32 + 8 * 32 + 2 * 32 * 2;
#define SEG(W, K, NS, C0, WD, WT, R0) { const int ni = ((K) / 64) * (((WD) + 31) / 32); if (r < ni) { tr_item(W, K, NS, C0, WD, WT, R0, scr, r, lane); continue; } r -= ni; }
    for (int it = gw; it < TOTAL; it += NGW) {
        int r = it;
        SEG(p.w_in, 1024, 5408, 0, 512, win, 0)
        SEG(p.w_in, 1024, 5408, 512, 768, win, 512)
        SEG(p.w_in, 1024, 5408, 1304, 1536, win, 1280)
        SEG(p.w_in, 1024, 5408, 2848, 512, win, 2816)
        SEG(p.w_in, 1024, 5408, 3360, 2048, win, 3328)
        SEG(p.w_in, 1024, 5408, 1280, 24, win, 5376)
        SEG(p.w_in, 1024, 5408, 2840, 4, win, 5400)
        SEG(p.w_in, 1024, 5408, 2844, 4, win, 5404)
        { const int ni = 16 * 4 * 44; if (r < ni) { const int seg = r >> 6; tr_item(p.w_up, 1024, 5632, (seg & 1) * 2816 + 128 * (seg >> 1), 128, (bf16_t*)(p.ws + WS_WUP), 128 * seg, scr, r & 63, lane); continue; } r -= ni; }
        SEG(p.w_dn, 2816, 1024, 0, 1024, (bf16_t*)(p.ws + WS_WDN), 0)
        SEG(p.w_o, 1024, 1024, 0, 1024, (bf16_t*)(p.ws + WS_WO), 0)
        SEG(p.w_nsa, 512, 1024, 0, 1024, (bf16_t*)(p.ws + WS_WNSA), 0)
        SEG(p.w_gdn, 512, 1024, 0, 1024, (bf16_t*)(p.ws + WS_WGDN), 0)
        SEG(p.cmp_w1, 2048, 64, 0, 64, (bf16_t*)(p.ws + WS_W1C), 0)
        SEG(p.cmp_w1 + 2048 * 64, 2048, 64, 0, 64, (bf16_t*)(p.ws + WS_W1C) + 64 * 2048, 0)
    }
#undef SEG
    const int gtid = blockIdx.x * 512 + threadIdx.x, gsz = gridDim.x * 512;
    for (int i = gtid; i < 224 * 1024 / 8; i += gsz) *(u32x4*)(win + (size_t)5408 * 1024 + (size_t)i * 8) = (u32x4){0u, 0u, 0u, 0u};
    bf16_t* xb = (bf16_t*)(p.ws + WS_R32);
    for (int i = gtid; i < M * DM / 8; i += gsz) { const f32x4 a = *(const f32x4*)(p.x + (size_t)i * 8), b = *(const f32x4*)(p.x + (size_t)i * 8 + 4); *(u32x4*)(xb + (size_t)i * 8) = pack8(a, b); }
}

DI void cmp_task(const Params& p, LAS unsigned char* lds, int task, int wave, int lane) {
    const int rt = task & 7, g = (task >> 3) & 1, b = (task >> 4) & 7, i = task >> 7;
    const bf16_t* hkv = (const bf16_t*)(p.ws + WS_HKV);
    const bf16_t* w1t = (const bf16_t*)(p.ws + WS_W1C) + (size_t)i * 64 * 2048;
    const float* pos = p.cmp_pos + i * 2048;
    LAS float* red = (LAS float*)lds;
    LAS float* gl = (LAS float*)(lds + 32768);
    const int row = lane & 15, quad = lane >> 4;
    int n = 16 * rt + row; if (n > 126) n = 126;
    f32x4 acc[4];
#pragma unroll
    for (int nt = 0; nt < 4; ++nt) acc[nt] = (f32x4){0.f, 0.f, 0.f, 0.f};
#pragma unroll
    for (int ks = 0; ks < 8; ++ks) {
        const int l = 4 * wave + (ks >> 1), d = (ks & 1) * 32 + quad * 8;
        const u32x4 raw = *(const u32x4*)(hkv + (size_t)(b * SEQ + 16 * n + l) * 768 + i * 128 + g * 64 + d);
        const f32x4 p0 = *(const f32x4*)(pos + l * 64 + d), p1 = *(const f32x4*)(pos + l * 64 + d + 4);
        float v[8];
#pragma unroll
        for (int e = 0; e < 8; ++e) { const unsigned w = raw[e >> 1]; v[e] = ((e & 1) ? __uint_as_float(w & 0xffff0000u) : __uint_as_float(w << 16)) + (e < 4 ? p0[e & 3] : p1[e & 3]); }
        u32x4 aw; aw.x = pk2(v[0], v[1]); aw.y = pk2(v[2], v[3]); aw.z = pk2(v[4], v[5]); aw.w = pk2(v[6], v[7]);
        const bf16x8 a = __builtin_bit_cast(bf16x8, aw);
        const int k = wave * 256 + ks * 32 + quad * 8;
#pragma unroll
        for (int nt = 0; nt < 4; ++nt) { const bf16x8 bb = *(const bf16x8*)(w1t + (size_t)(nt * 16 + row) * 2048 + k); acc[nt] = MFMA16(a, bb, acc[nt]); }
    }
#pragma unroll
    for (int nt = 0; nt < 4; ++nt)
#pragma unroll
        for (int jj = 0; jj < 4; ++jj) red[(wave * 16 + quad * 4 + jj) * 64 + nt * 16 + row] = acc[nt][jj];
    __syncthreads();
    const int tid = threadIdx.x;
#pragma unroll
    for (int e = 0; e < 2; ++e) { const int o = tid + 512 * e; float s = 0.f;
#pragma unroll
        for (int w = 0; w < 8; ++w) s += red[w * 1024 + o];
        const float u = 0.7978845608028654f * (s + 0.044715f * s * s * s);
        gl[o] = 0.5f * s * (1.f + tanhf(u)); }
    __syncthreads();
    const float* w2 = p.cmp_w2 + i * 4096;
    float* kvc = (float*)(p.ws + WS_KVC) + (size_t)((i * 16 + b * 2 + g) * 128) * 64;
#pragma unroll
    for (int e = 0; e < 2; ++e) { const int o = tid + 512 * e, r = o >> 6, j = o & 63; float s = 0.f;
#pragma unroll 8
        for (int k = 0; k < 64; ++k) s += gl[r * 64 + k] * w2[k * 64 + j];
        const int nn = 16 * rt + r; kvc[(size_t)nn * 64 + j] = (nn <= 126) ? s : 0.f; }
    __syncthreads();
}

constexpr int GP_XQ = 0, GP_XK = 33024, GP_KB = 66048, GP_QB = 83456, GP_VBT = 100864, GP_KGT = 119296, GP_MISC = 137728;
constexpr int GP_MM = 0, GP_TB = 33024;
DI void gdn_prep_task(const Params& p, LAS unsigned char* lds, int task, int wave, int lane) {
    const int tid = threadIdx.x;
    const int n = task & 31, h = (task >> 5) & 3, b = task >> 7;
    const int rowb = b * SEQ + n * 64;
    const bf16_t* hg = (const bf16_t*)(p.ws + WS_HG);
    const float* small = (const float*)(p.ws + WS_SMALL);
    LAS float* XQ = (LAS float*)(lds + GP_XQ); LAS float* XK = (LAS float*)(lds + GP_XK);
    LAS bf16_t* KB = (LAS bf16_t*)(lds + GP_KB); LAS bf16_t* QB = (LAS bf16_t*)(lds + GP_QB);
    LAS bf16_t* VBT = (LAS bf16_t*)(lds + GP_VBT); LAS bf16_t* KGT = (LAS bf16_t*)(lds + GP_KGT);
    LAS float* betaL = (LAS float*)(lds + GP_MISC); LAS float* gcL = betaL + 64; LAS float* rsqL = betaL + 128; LAS float* rskL = betaL + 192;
    LAS float* MMf = (LAS float*)(lds + GP_MM); LAS bf16_t* TB = (LAS bf16_t*)(lds + GP_TB);
    bf16_t* dob = (bf16_t*)p.out;
    bf16_t* wneg_g = dob + DO_WNEG + (size_t)task * 8192; bf16_t* qs_g = dob + DO_QS + (size_t)task * 8192;
    bf16_t* kst_g = dob + DO_KST + (size_t)task * 8192; bf16_t* ut_g = dob + DO_UT + (size_t)task * 8192;
    bf16_t* ap_g = (bf16_t*)(p.ws + WS_APERM) + (size_t)task * 4096;
    if (wave == 0) {
        const float braw = small[(size_t)(rowb + lane) * 32 + 24 + h], draw = small[(size_t)(rowb + lane) * 32 + 28 + h];
        const float z = draw + p.dt_bias[h];
        const float sp = fmaxf(z, 0.f) + log1pf(__expf(-fabsf(z)));
        float gc = -__expf(p.a_log[h]) * sp;
#pragma unroll
        for (int o = 1; o < 64; o <<= 1) { const float t = __shfl_up(gc, o); if (lane >= o) gc += t; }
        betaL[lane] = sigmoidf_(braw); gcL[lane] = gc;
        if (lane == 63) ((float*)(p.ws + WS_EGL))[task] = __expf(gc);
    }
    __syncthreads();
    for (int item = tid; item < 768; item += 512) {
        const int c = item % 384, th = item / 384, seg = c >> 7, dcol = c & 127, gcol = seg * 512 + h * 128 + dcol;
        const float w0 = p.gdn_conv[gcol], w1 = p.gdn_conv[1536 + gcol], w2 = p.gdn_conv[3072 + gcol], w3 = p.gdn_conv[4608 + gcol];
        const int ts0 = n * 64 + th * 32;
        const bf16_t* src = hg + (size_t)(b * SEQ) * 1536 + gcol;
        float x0 = (ts0 >= 3) ? bf2f(src[(size_t)(ts0 - 3) * 1536]) : 0.f, x1 = (ts0 >= 2) ? bf2f(src[(size_t)(ts0 - 2) * 1536]) : 0.f, x2 = (ts0 >= 1) ? bf2f(src[(size_t)(ts0 - 1) * 1536]) : 0.f;
#pragma unroll 8
        for (int tl = 0; tl < 32; ++tl) {
            const float x3 = bf2f(src[(size_t)(ts0 + tl) * 1536]);
            const float y = siluf_(w0 * x0 + w1 * x1 + w2 * x2 + w3 * x3);
            const int t = th * 32 + tl;
            if (seg == 0) XQ[t * 129 + dcol] = y; else if (seg == 1) XK[t * 129 + dcol] = y; else VBT[dcol * 72 + t] = f2bf(y * betaL[t]);
            x0 = x1; x1 = x2; x2 = x3;
        }
    }
    __syncthreads();
    { const int mat = tid >> 8, row = (tid >> 2) & 63, part = tid & 3; LAS float* X = mat ? XK : XQ; float s = 0.f;
#pragma unroll 8
      for (int d = 0; d < 32; ++d) { const float v = X[row * 129 + part * 32 + d]; s += v * v; }
      s += __shfl_xor(s, 1); s += __shfl_xor(s, 2);
      if (part == 0) { if (mat) rskL[row] = rsqrtf(s + 1e-6f); else rsqL[row] = rsqrtf(s + 1e-6f) * 0.08838834764831845f; } }
    __syncthreads();
    const float glast = gcL[63];
    for (int e = tid; e < 8192; e += 512) { const int t = e >> 7, d = e & 127;
        const float kn = XK[t * 129 + d] * rskL[t], qn = XQ[t * 129 + d] * rsqL[t];
        KB[t * 136 + d] = f2bf(kn); QB[t * 136 + d] = f2bf(qn);
        qs_g[t * 128 + posperm(d)] = f2bf(qn * __expf(gcL[t])); }
    for (int e = tid; e < 8192; e += 512) { const int d = e >> 6, t = e & 63;
        const float kn = XK[t * 129 + d] * rskL[t];
        KGT[d * 72 + t] = f2bf(kn * betaL[t] * __expf(gcL[t]));
        kst_g[d * 64 + posperm(t)] = f2bf(kn * __expf(glast - gcL[t])); }
    __syncthreads();
    { const int row = lane & 15, quad = lane >> 4;
#pragma unroll
      for (int jb = 0; jb < 2; ++jb) { const int tt = wave * 2 + jb, ti = tt >> 2, tj = tt & 3;
        f32x4 ak = {0.f, 0.f, 0.f, 0.f}, aq = {0.f, 0.f, 0.f, 0.f};
        if (tj <= ti) {
#pragma unroll
            for (int pp = 0; pp < 4; ++pp) { const bf16x8 bk = *(const LAS bf16x8*)(KB + (16 * tj + row) * 136 + 32 * pp + 8 * quad);
                const bf16x8 a_k = *(const LAS bf16x8*)(KB + (16 * ti + row) * 136 + 32 * pp + 8 * quad), a_q = *(const LAS bf16x8*)(QB + (16 * ti + row) * 136 + 32 * pp + 8 * quad);
                ak = MFMA16(a_k, bk, ak); aq = MFMA16(a_q, bk, aq); } }
        const int j = 16 * tj + row; const float gj = gcL[j];
#pragma unroll
        for (int jj = 0; jj < 4; ++jj) { const int i = 16 * ti + 4 * quad + jj; const float dec = __expf(fminf(gcL[i] - gj, 0.f));
            MMf[i * 68 + j] = (j < i) ? betaL[i] * ak[jj] * dec : 0.f;
            ap_g[i * 64 + posperm(j)] = f2bf((j <= i) ? aq[jj] * dec : 0.f); } } }
    __syncthreads();
    if (wave == 0) {
        float t[64];
#pragma unroll
        for (int i = 0; i < 64; ++i) {
            float a = (i == lane) ? 1.f : 0.f;
#pragma unroll
            for (int j4 = 0; j4 < (i + 3) / 4; ++j4) { const f32x4 m4 = *(const LAS f32x4*)(MMf + i * 68 + 4 * j4);
#pragma unroll
                for (int e = 0; e < 4; ++e) if (4 * j4 + e < i) a -= m4[e] * t[4 * j4 + e]; }
            t[i] = a;
        }
        asm volatile("s_waitcnt lgkmcnt(0)" ::: "memory");
#pragma unroll
        for (int i = 0; i < 64; ++i) TB[i * 72 + lane] = f2bf(t[i]);
    }
    __syncthreads();
    { const int row = lane & 15, quad = lane >> 4;
      f32x4 au[4], aw[4];
#pragma unroll
      for (int i = 0; i < 4; ++i) { au[i] = (f32x4){0.f, 0.f, 0.f, 0.f}; aw[i] = (f32x4){0.f, 0.f, 0.f, 0.f}; }
#pragma unroll
      for (int pp = 0; pp < 2; ++pp) {
          const bf16x8 bv = *(const LAS bf16x8*)(VBT + (16 * wave + row) * 72 + 32 * pp + 8 * quad);
          const bf16x8 akg = *(const LAS bf16x8*)(KGT + (16 * wave + row) * 72 + 32 * pp + 8 * quad);
#pragma unroll
          for (int i = 0; i < 4; ++i) { const bf16x8 tb = *(const LAS bf16x8*)(TB + (16 * i + row) * 72 + 32 * pp + 8 * quad);
              au[i] = MFMA16(tb, bv, au[i]);
              aw[i] = MFMA16(akg, tb, aw[i]); }
      }
#pragma unroll
      for (int i = 0; i < 4; ++i) {
          u32x2 uw; uw.x = pk2(au[i][0], au[i][1]); uw.y = pk2(au[i][2], au[i][3]);
          *(u32x2*)(ut_g + (16 * wave + row) * 64 + 16 * i + 4 * quad) = uw;
          u32x2 ww; ww.x = pk2(-aw[i][0], -aw[i][1]); ww.y = pk2(-aw[i][2], -aw[i][3]);
          *(u32x2*)(wneg_g + (16 * i + row) * 128 + 32 * (wave >> 1) + 8 * quad + 4 * (wave & 1)) = ww; } }
    __syncthreads();
}

constexpr int GS_BUF = 62464, GS_QS = 17408, GS_A = 34816, GS_KST = 44032, GS_PART = 2 * GS_BUF;
DI void gdn_scan(const Params& p, LAS unsigned char* lds, int bh, int wave, int lane) {
    const int tid = threadIdx.x, b = bh >> 2, h = bh & 3;
    const bf16_t* dob = (const bf16_t*)p.out;
    const bf16_t* hgg = (const bf16_t*)(p.ws + WS_HGG);
    const float* egl = (const float*)(p.ws + WS_EGL) + bh * 32;
    bf16_t* gdn_o = (bf16_t*)(p.ws + WS_R32) + (size_t)M * 512;
    LAS float* part = (LAS float*)(lds + GS_PART);
    const int col = lane & 15, quad = lane >> 4, n0 = 16 * wave;
    const float nw = p.norm_w[n0 + col];
    unsigned goff[7], loff[7];
#pragma unroll
    for (int k = 0; k < 7; ++k) { const int pc = tid + 512 * k;
        if (k < 2) { goff[k] = (unsigned)(DO_WNEG) + pc * 8; loff[k] = (pc >> 4) * 272 + (pc & 15) * 16; }
        else if (k < 4) { const int q = pc - 1024; goff[k] = (unsigned)(DO_QS) + q * 8; loff[k] = GS_QS + (q >> 4) * 272 + (q & 15) * 16; }
        else if (k < 5) { const int q = pc - 2048; goff[k] = 0xffffffffu; loff[k] = GS_A + (q >> 3) * 144 + (q & 7) * 16; }
        else { const int q = pc - 2560; goff[k] = (unsigned)(DO_KST) + q * 8; loff[k] = GS_KST + (q >> 3) * 144 + (q & 7) * 16; } }
    const bf16_t* ap_base = (const bf16_t*)(p.ws + WS_APERM);
    u32x4 stg[7];
#define GS_LOAD(ch) do { const size_t cb = (size_t)(ch) * 8192; _Pragma("unroll") for (int k = 0; k < 7; ++k) { \
        if (k == 4) stg[k] = *(const u32x4*)(ap_base + (size_t)(ch) * 4096 + (tid + 512 * 4 - 2048) * 8); else stg[k] = *(const u32x4*)(dob + cb + goff[k]); } } while (0)
#define GS_STORE(bufi) do { _Pragma("unroll") for (int k = 0; k < 7; ++k) *(LAS u32x4*)(lds + (bufi) * GS_BUF + loff[k]) = stg[k]; } while (0)
    f32x4 S[8];
#pragma unroll
    for (int t = 0; t < 8; ++t) S[t] = (f32x4){0.f, 0.f, 0.f, 0.f};
    const int ch0 = bh * 32;
    GS_LOAD(ch0); GS_STORE(0);
    __syncthreads();
    for (int n = 0; n < 32; ++n) {
        const int ch = ch0 + n;
        if (n + 1 < 32) GS_LOAD(ch + 1);
        const LAS unsigned char* buf = lds + (n & 1) * GS_BUF;
        f32x4 V[4], O[4];
        const bf16_t* utp = dob + DO_UT + (size_t)ch * 8192 + (n0 + col) * 64 + 4 * quad;
        u32x2 uraw[4];
#pragma unroll
        for (int i = 0; i < 4; ++i) uraw[i] = *(const u32x2*)(utp + 16 * i);
        const size_t orow0 = (size_t)(b * SEQ + n * 64);
        unsigned short graw[16];
#pragma unroll
        for (int i = 0; i < 4; ++i)
#pragma unroll
            for (int jj = 0; jj < 4; ++jj) graw[i * 4 + jj] = hgg[(orow0 + 16 * i + 4 * quad + jj) * 512 + h * 128 + n0 + col];
        const float eg = egl[n];
#pragma unroll
        for (int i = 0; i < 4; ++i) { V[i] = (f32x4){__uint_as_float(uraw[i].x << 16), __uint_as_float(uraw[i].x & 0xffff0000u), __uint_as_float(uraw[i].y << 16), __uint_as_float(uraw[i].y & 0xffff0000u)};
            O[i] = (f32x4){0.f, 0.f, 0.f, 0.f}; }
        bf16x8 Sop[4];
#pragma unroll
        for (int pp = 0; pp < 4; ++pp) { u32x4 w; w.x = pk2(S[2 * pp][0], S[2 * pp][1]); w.y = pk2(S[2 * pp][2], S[2 * pp][3]); w.z = pk2(S[2 * pp + 1][0], S[2 * pp + 1][1]); w.w = pk2(S[2 * pp + 1][2], S[2 * pp + 1][3]); Sop[pp] = __builtin_bit_cast(bf16x8, w); }
#pragma unroll
        for (int i = 0; i < 4; ++i)
#pragma unroll
            for (int pp = 0; pp < 4; ++pp) { const bf16x8 aw = *(const LAS bf16x8*)(buf + (16 * i + col) * 272 + (32 * pp + 8 * quad) * 2);
                const bf16x8 aq = *(const LAS bf16x8*)(buf + GS_QS + (16 * i + col) * 272 + (32 * pp + 8 * quad) * 2);
                V[i] = MFMA16(aw, Sop[pp], V[i]); O[i] = MFMA16(aq, Sop[pp], O[i]); }
        bf16x8 Vop[2];
#pragma unroll
        for (int pp = 0; pp < 2; ++pp) { u32x4 w; w.x = pk2(V[2 * pp][0], V[2 * pp][1]); w.y = pk2(V[2 * pp][2], V[2 * pp][3]); w.z = pk2(V[2 * pp + 1][0], V[2 * pp + 1][1]); w.w = pk2(V[2 * pp + 1][2], V[2 * pp + 1][3]); Vop[pp] = __builtin_bit_cast(bf16x8, w); }
#pragma unroll
        for (int i = 0; i < 4; ++i)
#pragma unroll
            for (int pp = 0; pp < 2; ++pp) { const bf16x8 aa = *(const LAS bf16x8*)(buf + GS_A + (16 * i + col) * 144 + (32 * pp + 8 * quad) * 2); O[i] = MFMA16(aa, Vop[pp], O[i]); }
#pragma unroll
        for (int t = 0; t < 8; ++t) { S[t] = S[t] * eg;
#pragma unroll
            for (int pp = 0; pp < 2; ++pp) { const bf16x8 ak = *(const LAS bf16x8*)(buf + GS_KST + (16 * t + col) * 144 + (32 * pp + 8 * quad) * 2); S[t] = MFMA16(ak, Vop[pp], S[t]); } }
#pragma unroll
        for (int i = 0; i < 4; ++i)
#pragma unroll
            for (int jj = 0; jj < 4; ++jj) { float s = O[i][jj] * O[i][jj]; s += __shfl_xor(s, 1); s += __shfl_xor(s, 2); s += __shfl_xor(s, 4); s += __shfl_xor(s, 8);
                if (col == 0) part[wave * 64 + 16 * i + 4 * quad + jj] = s; }
        __syncthreads();
#pragma unroll
        for (int i = 0; i < 4; ++i)
#pragma unroll
            for (int jj = 0; jj < 4; ++jj) { const int c = 16 * i + 4 * quad + jj; float s = 0.f;
#pragma unroll
                for (int w = 0; w < 8; ++w) s += part[w * 64 + c];
                const float rstd = rsqrtf(s * (1.f / 128.f) + 1e-6f);
                const float gt = bf2f(graw[i * 4 + jj]);
                gdn_o[(orow0 + c) * 512 + h * 128 + n0 + col] = f2bf(O[i][jj] * rstd * nw * siluf_(gt)); }
        if (n + 1 < 32) GS_STORE((n + 1) & 1);
        __syncthreads();
    }
#undef GS_LOAD
#undef GS_STORE
}

constexpr int NA_KS = 0, NA_VT = 18432, NA_PS = 36864, NA_SELM = 70656, NA_UNI = 70912, NA_Q = 71168;
constexpr int NA_TILE = 9216;
struct NsaState { float m, l; f32x16 o0, o1; };
template <int MODE>
DI void nsa_tile(LAS unsigned char* lds, int bufi, const bf16x8 (&qf)[4], NsaState& st, int kbase, int t, int hi, int lane, float c1, float slope2, bool sel) {
    const LAS bf16_t* KS = (const LAS bf16_t*)(lds + NA_KS + bufi * NA_TILE);
    const LAS bf16_t* VT = (const LAS bf16_t*)(lds + NA_VT + bufi * NA_TILE);
    const int ql = lane & 31;
    f32x16 s0, s1;
#pragma unroll
    for (int r = 0; r < 16; ++r) { s0[r] = 0.f; s1[r] = 0.f; }
#pragma unroll
    for (int kk = 0; kk < 4; ++kk) {
        const bf16x8 a0 = *(const LAS bf16x8*)(KS + ql * 72 + 16 * kk + 8 * hi), a1 = *(const LAS bf16x8*)(KS + (32 + ql) * 72 + 16 * kk + 8 * hi);
        s0 = MFMA32(a0, qf[kk], s0); s1 = MFMA32(a1, qf[kk], s1);
    }
    float sl = slope2; asm volatile("" : "+v"(sl));
    const int dq = t - 4 * hi - kbase;
    const float base = -sl * (float)dq;
    float mx = -INFINITY;
#pragma unroll
    for (int r = 0; r < 16; ++r) {
        const int c0 = (r & 3) + 8 * (r >> 2), c1k = 32 + c0;
        bool v0 = sel && dq >= c0, v1 = sel && dq >= c1k;
        if (MODE == 1) { v0 = v0 && dq < 512 + c0; v1 = v1 && dq < 512 + c1k; }
        s0[r] = v0 ? (s0[r] * c1 + (base + sl * (float)c0)) : -INFINITY;
        s1[r] = v1 ? (s1[r] * c1 + (base + sl * (float)c1k)) : -INFINITY;
        mx = fmaxf(mx, fmaxf(s0[r], s1[r]));
    }
    mx = fmaxf(mx, __shfl_xor(mx, 32));
    const float mnew = fmaxf(st.m, mx);
    const float al = __builtin_amdgcn_exp2f(st.m - mnew);
    float rs = 0.f;
#pragma unroll
    for (int r = 0; r < 16; ++r) { s0[r] = __builtin_amdgcn_exp2f(s0[r] - mnew); s1[r] = __builtin_amdgcn_exp2f(s1[r] - mnew); rs += s0[r] + s1[r]; }
    rs += __shfl_xor(rs, 32);
    st.l = st.l * al + rs; st.m = mnew;
#pragma unroll
    for (int r = 0; r < 16; ++r) { st.o0[r] *= al; st.o1[r] *= al; }
#pragma unroll
    for (int sub = 0; sub < 2; ++sub)
#pragma unroll
        for (int u = 0; u < 2; ++u) {
            u32x4 pw;
            if (sub == 0) { pw.x = pk2(s0[8 * u], s0[8 * u + 1]); pw.y = pk2(s0[8 * u + 2], s0[8 * u + 3]); pw.z = pk2(s0[8 * u + 4], s0[8 * u + 5]); pw.w = pk2(s0[8 * u + 6], s0[8 * u + 7]); }
            else { pw.x = pk2(s1[8 * u], s1[8 * u + 1]); pw.y = pk2(s1[8 * u + 2], s1[8 * u + 3]); pw.z = pk2(s1[8 * u + 4], s1[8 * u + 5]); pw.w = pk2(s1[8 * u + 6], s1[8 * u + 7]); }
            const bf16x8 pb = __builtin_bit_cast(bf16x8, pw);
            const int kc = 32 * sub + 16 * u + 4 * hi;
            const s16x4 v00 = *(const LAS s16x4*)(VT + ql * 72 + kc), v01 = *(const LAS s16x4*)(VT + ql * 72 + kc + 8);
            const s16x4 v10 = *(const LAS s16x4*)(VT + (32 + ql) * 72 + kc), v11 = *(const LAS s16x4*)(VT + (32 + ql) * 72 + kc + 8);
            const bf16x8 va0 = {v00[0], v00[1], v00[2], v00[3], v01[0], v01[1], v01[2], v01[3]}, va1 = {v10[0], v10[1], v10[2], v10[3], v11[0], v11[1], v11[2], v11[3]};
            st.o0 = MFMA32(va0, pb, st.o0); st.o1 = MFMA32(va1, pb, st.o1);
        }
}
DI void nsa_ld(const bf16_t* hkv, int b, int g, int j, int kcol, u32x4& kr, u32x4& vr, int tid) {
    const int key = tid >> 3, d8 = (tid & 7) * 8; const bf16_t* src = hkv + (size_t)(b * SEQ + 64 * j + key) * 768 + g * 64 + d8;
    kr = *(const u32x4*)(src + kcol); vr = *(const u32x4*)(src + kcol + 128);
}
DI void nsa_st(LAS unsigned char* lds, int bufi, const u32x4& kr, const u32x4& vr, int tid) {
    const int key = tid >> 3, d8 = (tid & 7) * 8;
    *(LAS u32x4*)(lds + NA_KS + bufi * NA_TILE + (key * 72 + d8) * 2) = kr;
    LAS bf16_t* VT = (LAS bf16_t*)(lds + NA_VT + bufi * NA_TILE);
#pragma unroll
    for (int e = 0; e < 8; ++e) { const unsigned w = vr[e >> 1]; VT[(d8 + e) * 72 + key] = (unsigned short)((e & 1) ? (w >> 16) : (w & 0xffffu)); }
}
template <int MODE>
DI void nsa_branch(const Params& p, LAS unsigned char* lds, unsigned U, int b, int g, int kcol, const bf16x8 (&qf)[4], NsaState& st, int t, int hi, int lane, float c1, float slope2, unsigned myselm) {
    const bf16_t* hkv = (const bf16_t*)(p.ws + WS_HKV);
    const int tid = threadIdx.x;
    u32x4 kr, vr;
    unsigned rem = U;
    int j = __builtin_ctz(rem); rem &= rem - 1;
    nsa_ld(hkv, b, g, j, kcol, kr, vr, tid); nsa_st(lds, 0, kr, vr, tid);
    __syncthreads();
    int it = 0;
    for (;;) {
        const bool more = rem != 0u; int jn = 0;
        if (more) { jn = __builtin_ctz(rem); rem &= rem - 1; nsa_ld(hkv, b, g, jn, kcol, kr, vr, tid); }
        const bool sel = (MODE == 1) ? true : (((myselm >> j) & 1u) != 0u);
        if (__any(sel)) nsa_tile<MODE>(lds, it & 1, qf, st, 64 * j, t, hi, lane, c1, slope2, sel);
        if (more) nsa_st(lds, (it + 1) & 1, kr, vr, tid);
        __syncthreads();
        if (!more) break;
        j = jn; ++it;
    }
}
DI void nsa_unit(const Params& p, LAS unsigned char* lds, int unit, int wave, int lane) {
    const int tid = threadIdx.x;
    const int qb = 31 - (unit >> 4), bg = unit & 15, b = bg >> 1, g = bg & 1;
    const int t0 = qb * 64, ql = lane & 31, hi = lane >> 5, tl = 8 * wave + (ql >> 2), r = ql & 3, h = 4 * g + r, t = t0 + tl;
    const size_t rowg = (size_t)b * SEQ + t;
    const bf16_t* hq = (const bf16_t*)(p.ws + WS_HQ);
    const float* small = (const float*)(p.ws + WS_SMALL);
    bf16x8 qf[4];
#pragma unroll
    for (int kk = 0; kk < 4; ++kk) qf[kk] = *(const bf16x8*)(hq + rowg * 512 + h * 64 + 16 * kk + 8 * hi);
    const float slope2 = __builtin_amdgcn_exp2f(-(float)(h + 1)) * LOG2E, c1 = 0.125f * LOG2E;
    const float gc = sigmoidf_(small[rowg * 32 + h]), gs = sigmoidf_(small[rowg * 32 + 8 + h]), gw = sigmoidf_(small[rowg * 32 + 16 + h]);
    f32x16 oa0, oa1;
    LAS float* PS = (LAS float*)(lds + NA_PS);
    LAS unsigned* SELM = (LAS unsigned*)(lds + NA_SELM);
    LAS unsigned* UNI = (LAS unsigned*)(lds + NA_UNI);
    {
        const float* kc = (const float*)(p.ws + WS_KVC) + (size_t)((b * 2 + g) * 128) * 64;
        const float* vc = kc + (size_t)16 * 128 * 64;
        const int key = tid >> 2, d0 = (tid & 3) * 16, kb = key >> 6, kl = key & 63;
        f32x4 a[4], v[4];
#pragma unroll
        for (int e = 0; e < 4; ++e) { a[e] = *(const f32x4*)(kc + key * 64 + d0 + 4 * e); v[e] = *(const f32x4*)(vc + key * 64 + d0 + 4 * e); }
        *(LAS u32x4*)(lds + NA_KS + kb * NA_TILE + (kl * 72 + d0) * 2) = pack8(a[0], a[1]);
        *(LAS u32x4*)(lds + NA_KS + kb * NA_TILE + (kl * 72 + d0 + 8) * 2) = pack8(a[2], a[3]);
        LAS bf16_t* VT = (LAS bf16_t*)(lds + NA_VT + kb * NA_TILE);
#pragma unroll
        for (int e = 0; e < 16; ++e) VT[(d0 + e) * 72 + kl] = f2bf(v[e >> 2][e & 3]);
    }
    __syncthreads();
    {
        int ncmp = 4 * qb + 3; if (ncmp > 127) ncmp = 127;
        const int nsub = (ncmp + 31) >> 5;
        float m = -1.0e30f, l = 0.f;
        float slc = slope2; asm volatile("" : "+v"(slc));
        const int tq16 = t - 64 * hi - 31;
        const float basec = -slc * (float)tq16;
#pragma unroll
        for (int sub = 0; sub < 4; ++sub) {
            if (sub < nsub) {
                f32x16 sc;
#pragma unroll
                for (int i = 0; i < 16; ++i) sc[i] = 0.f;
                const LAS bf16_t* KS = (const LAS bf16_t*)(lds + NA_KS + (sub >> 1) * NA_TILE) + ((sub & 1) * 32 + ql) * 72 + 8 * hi;
#pragma unroll
                for (int kk = 0; kk < 4; ++kk) sc = MFMA32(*(const LAS bf16x8*)(KS + 16 * kk), qf[kk], sc);
                float mx = -INFINITY;
#pragma unroll
                for (int i = 0; i < 16; ++i) { const int cn = 16 * (32 * sub + (i & 3) + 8 * (i >> 2));
                    const bool val = (tq16 >= cn) && !(sub == 3 && i == 15 && hi == 1);
                    sc[i] = val ? (sc[i] * c1 + (basec + slc * (float)cn)) : -INFINITY; mx = fmaxf(mx, sc[i]); }
                mx = fmaxf(mx, __shfl_xor(mx, 32));
                const float mnew = fmaxf(m, mx);
                float rs = 0.f;
#pragma unroll
                for (int i = 0; i < 16; ++i) rs += __builtin_amdgcn_exp2f(sc[i] - mnew);
                rs += __shfl_xor(rs, 32);
                l = l * __builtin_amdgcn_exp2f(m - mnew) + rs; m = mnew;
            }
            asm volatile("" ::: "memory");
        }
        const float inv = (l > 0.f) ? 1.f / l : 0.f;
        f32x16 o0, o1;
#pragma unroll
        for (int i = 0; i < 16; ++i) { o0[i] = 0.f; o1[i] = 0.f; }
#pragma unroll
        for (int sub = 0; sub < 4; ++sub) {
            f32x16 sc;
#pragma unroll
            for (int i = 0; i < 16; ++i) sc[i] = 0.f;
            if (sub < nsub) {
                const LAS bf16_t* KS = (const LAS bf16_t*)(lds + NA_KS + (sub >> 1) * NA_TILE) + ((sub & 1) * 32 + ql) * 72 + 8 * hi;
#pragma unroll
                for (int kk = 0; kk < 4; ++kk) sc = MFMA32(*(const LAS bf16x8*)(KS + 16 * kk), qf[kk], sc);
#pragma unroll
                for (int i = 0; i < 16; ++i) { const int cn = 16 * (32 * sub + (i & 3) + 8 * (i >> 2));
                    const bool val = (tq16 >= cn) && !(sub == 3 && i == 15 && hi == 1);
                    sc[i] = val ? __builtin_amdgcn_exp2f((sc[i] * c1 + (basec + slc * (float)cn)) - m) * inv : 0.f; }
            }
#pragma unroll
            for (int q = 0; q < 4; ++q) { float gsum = (sc[4 * q] + sc[4 * q + 1]) + (sc[4 * q + 2] + sc[4 * q + 3]), lst = sc[4 * q + 3];
                gsum += __shfl_xor(gsum, 1); gsum += __shfl_xor(gsum, 2); lst += __shfl_xor(lst, 1); lst += __shfl_xor(lst, 2);
                if (r == 0) *(LAS f32x2*)(PS + tl * 66 + 2 * (8 * sub + 2 * q + hi)) = (f32x2){gsum, lst}; }
            if (sub < nsub) {
                const LAS bf16_t* VT = (const LAS bf16_t*)(lds + NA_VT + (sub >> 1) * NA_TILE);
#pragma unroll
                for (int u = 0; u < 2; ++u) {
                    u32x4 pw; pw.x = pk2(sc[8 * u], sc[8 * u + 1]); pw.y = pk2(sc[8 * u + 2], sc[8 * u + 3]); pw.z = pk2(sc[8 * u + 4], sc[8 * u + 5]); pw.w = pk2(sc[8 * u + 6], sc[8 * u + 7]);
                    const bf16x8 pb = __builtin_bit_cast(bf16x8, pw);
                    const int kc2 = (sub & 1) * 32 + 16 * u + 4 * hi;
                    const s16x4 v00 = *(const LAS s16x4*)(VT + ql * 72 + kc2), v01 = *(const LAS s16x4*)(VT + ql * 72 + kc2 + 8);
                    const s16x4 v10 = *(const LAS s16x4*)(VT + (32 + ql) * 72 + kc2), v11 = *(const LAS s16x4*)(VT + (32 + ql) * 72 + kc2 + 8);
                    const bf16x8 va0 = {v00[0], v00[1], v00[2], v00[3], v01[0], v01[1], v01[2], v01[3]}, va1 = {v10[0], v10[1], v10[2], v10[3], v11[0], v11[1], v11[2], v11[3]};
                    o0 = MFMA32(va0, pb, o0); o1 = MFMA32(va1, pb, o1);
                }
            }
            asm volatile("" ::: "memory");
        }
#pragma unroll
        for (int i = 0; i < 16; ++i) { oa0[i] = gc * o0[i]; oa1[i] = gc * o1[i]; }
    }
    __syncthreads();
    if (wave == 0) {
        const LAS float* pr = PS + lane * 66;
        float scv[32]; float lprev = 0.f;
#pragma unroll
        for (int j = 0; j < 32; ++j) { const f32x2 q2 = *(const LAS f32x2*)(pr + 2 * j); scv[j] = q2[0] + lprev; lprev = q2[1]; if ((j & 7) == 7) asm volatile("" ::: "memory"); }
#pragma unroll
        for (int j = 0; j < 32; ++j) { if (j == 0 || j == qb || j == qb - 1) scv[j] = 1.0e4f; else if (j > qb) scv[j] = -1.f; }
        unsigned msk = 0u;
#pragma unroll
        for (int k = 0; k < 8; ++k) { float best = -INFINITY; int bi = 0;
#pragma unroll
            for (int j = 0; j < 32; ++j) { const bool free_ = ((msk >> j) & 1u) == 0u; if (free_ && scv[j] > best) { best = scv[j]; bi = j; } }
            msk |= 1u << bi; }
        msk &= (2u << qb) - 1u;
        SELM[lane] = msk;
        unsigned un = msk;
#pragma unroll
        for (int o = 1; o < 64; o <<= 1) un |= __shfl_xor(un, o);
        if (lane == 0) UNI[0] = un;
    }
    __syncthreads();
    const unsigned myselm = SELM[tl]; const unsigned U = UNI[0];
    {
        NsaState st; st.m = -1.0e30f; st.l = 0.f;
#pragma unroll
        for (int i = 0; i < 16; ++i) { st.o0[i] = 0.f; st.o1[i] = 0.f; }
        nsa_branch<0>(p, lds, U, b, g, 256, qf, st, t, hi, lane, c1, slope2, myselm);
        const float f = (st.l > 0.f) ? gs / st.l : 0.f;
#pragma unroll
        for (int i = 0; i < 16; ++i) { oa0[i] += f * st.o0[i]; oa1[i] += f * st.o1[i]; }
    }
    {
        NsaState st; st.m = -1.0e30f; st.l = 0.f;
#pragma unroll
        for (int i = 0; i < 16; ++i) { st.o0[i] = 0.f; st.o1[i] = 0.f; }
        const int jlo = qb >= 8 ? qb - 8 : 0;
        const unsigned W = ((2u << qb) - 1u) & ~((1u << jlo) - 1u);
        nsa_branch<1>(p, lds, W, b, g, 512, qf, st, t, hi, lane, c1, slope2, 0u);
        const float f = (st.l > 0.f) ? gw / st.l : 0.f;
#pragma unroll
        for (int i = 0; i < 16; ++i) { oa0[i] += f * st.o0[i]; oa1[i] += f * st.o1[i]; }
    }
    bf16_t* no = (bf16_t*)(p.ws + WS_R32) + rowg * 512 + h * 64;
#pragma unroll
    for (int q4 = 0; q4 < 4; ++q4) {
        u32x2 w0; w0.x = pk2(oa0[4 * q4], oa0[4 * q4 + 1]); w0.y = pk2(oa0[4 * q4 + 2], oa0[4 * q4 + 3]);
        u32x2 w1; w1.x = pk2(oa1[4 * q4], oa1[4 * q4 + 1]); w1.y = pk2(oa1[4 * q4 + 2], oa1[4 * q4 + 3]);
        *(u32x2*)(no + 8 * q4 + 4 * hi) = w0; *(u32x2*)(no + 32 + 8 * q4 + 4 * hi) = w1;
    }
    __syncthreads();
}

DI void ln_rows(const float* zin, float* xout, bf16_t* xb, const float* gam, const float* bet, int gw, int NGW, int lane) {
    f32x4 gv[4], bv[4];
#pragma unroll
    for (int j = 0; j < 4; ++j) { gv[j] = *(const f32x4*)(gam + lane * 4 + 256 * j); bv[j] = *(const f32x4*)(bet + lane * 4 + 256 * j); }
    for (int m = gw; m < M; m += NGW) {
        const float* zr = zin + (size_t)m * DM + lane * 4;
        f32x4 v[4]; float s = 0.f;
#pragma unroll
        for (int j = 0; j < 4; ++j) { v[j] = *(const f32x4*)(zr + 256 * j); s += (v[j][0] + v[j][1]) + (v[j][2] + v[j][3]); }
        const float mean = wave_sum(s) * (1.f / DM); float s2 = 0.f;
#pragma unroll
        for (int j = 0; j < 4; ++j) { v[j] = v[j] - mean; s2 += (v[j][0] * v[j][0] + v[j][1] * v[j][1]) + (v[j][2] * v[j][2] + v[j][3] * v[j][3]); }
        const float rstd = rsqrtf(wave_sum(s2) * (1.f / DM) + 1e-5f);
#pragma unroll
        for (int j = 0; j < 4; ++j) { const f32x4 o = v[j] * rstd * gv[j] + bv[j];
            *(f32x4*)(xout + (size_t)m * DM + lane * 4 + 256 * j) = o;
            if (xb) { u32x2 w; w.x = pk2(o[0], o[1]); w.y = pk2(o[2], o[3]); *(u32x2*)(xb + (size_t)m * DM + lane * 4 + 256 * j) = w; } }
    }
}

constexpr int NPHASE = 11;
__global__ void __launch_bounds__(512, 2) fwd_kernel(Params p) {
    extern __shared__ __attribute__((aligned(16))) unsigned char lds_raw[];
    LAS unsigned char* lds = (LAS unsigned char*)lds_raw;
    cg::grid_group grid = cg::this_grid();
    const int tid = threadIdx.x, lane = tid & 63, wave = __builtin_amdgcn_readfirstlane(tid >> 6);
    const int G = gridDim.x, bx = blockIdx.x;
    const int lo = p.ph_lo, hi = p.ph_hi;
    unsigned* ctl = (unsigned*)(p.ws + WS_CTL);
#ifndef PHMASK
#define PHMASK 0xffff
#endif
#define IN(k) (((PHMASK >> (k)) & 1) && lo <= (k) && (k) < hi)
#define SEAM(k) do { if (IN(k) && IN((k) + 1)) grid.sync(); } while (0)
    bf16_t* const r32 = (bf16_t*)(p.ws + WS_R32);
    if (IN(0)) { p0_prologue(p, lds, wave, lane); }
    SEAM(0);
    if (IN(1)) {
        pg8::Gemm g{r32, (const bf16_t*)(p.ws + WS_WIN), M, NIN, DM, DM, 0, 256}; pg8::StaticOrder S; S.init(M, NIN, G, bx);
        EpiH E{(bf16_t*)(p.ws + WS_HQ), (bf16_t*)(p.ws + WS_HKV), (bf16_t*)(p.ws + WS_HG), (bf16_t*)(p.ws + WS_HGG), (bf16_t*)(p.ws + WS_HM), (float*)(p.ws + WS_SMALL)};
        pg8::gemm_phase<EpiH>(lds, g, S, E);
    }
    SEAM(1);
    if (IN(2)) {
        for (int task = bx; task < 256; task += G) cmp_task(p, lds, task, wave, lane);
        for (int task = bx; task < 1024; task += G) gdn_prep_task(p, lds, task, wave, lane);
    }
    SEAM(2);
    if (IN(3)) {
        if (bx < 32) gdn_scan(p, lds, bx, wave, lane);
        LAS unsigned* qslot = (LAS unsigned*)(lds + NA_Q);
        for (;;) {
            __syncthreads();
            if (tid == 0) qslot[0] = atomicAdd(ctl + p.rep, 1u);
            __syncthreads();
            const unsigned unit = qslot[0];
            if (unit >= 512u) break;
            nsa_unit(p, lds, (int)unit, wave, lane);
        }
    }
    SEAM(3);
    if (IN(4)) {
        bf16_t* mix = (bf16_t*)(p.ws + WS_MIX);
        { pg8::Gemm g{r32, (const bf16_t*)(p.ws + WS_WNSA), M, DM, 512, 512, 0, 256}; pg8::StaticOrder S; S.init(M, DM, G, bx);
          EpiGate<0> E{(const bf16_t*)(p.ws + WS_HM), mix}; pg8::gemm_phase<EpiGate<0>>(lds, g, S, E); }
        { pg8::Gemm g{r32 + (size_t)M * 512, (const bf16_t*)(p.ws + WS_WGDN), M, DM, 512, 512, 0, 256}; pg8::StaticOrder S; S.init(M, DM, G, bx);
          EpiGate<1> E{(const bf16_t*)(p.ws + WS_HM), mix}; pg8::gemm_phase<EpiGate<1>>(lds, g, S, E); }
    }
    SEAM(4);
    if (IN(5)) {
        pg8::Gemm g{(const bf16_t*)(p.ws + WS_MIX), (const bf16_t*)(p.ws + WS_WO), M, DM, DM, DM, 0, 256}; pg8::StaticOrder S; S.init(M, DM, G, bx);
        EpiZ E{p.x, p.out}; pg8::gemm_phase<EpiZ>(lds, g, S, E);
    }
    SEAM(5);
    if (IN(6)) { ln_rows(p.out, p.out, r32, p.ln1g, p.ln1b, bx * 8 + wave, G * 8, lane); }
    SEAM(6);
    if (IN(7)) {
        pg8::Gemm g{r32, (const bf16_t*)(p.ws + WS_WUP), M, FF2, DM, DM, -2, 254}; pg8::StaticOrder S; S.init2(65, 22, G, bx);
        EpiUpAct E{(bf16_t*)(p.ws + WS_ACT), p.ffn_conv, (LAS float*)(lds + 131072)}; pg8::gemm_phase<EpiUpAct>(lds, g, S, E);
    }
    SEAM(7);
    SEAM(8);
    if (IN(9)) {
        pg8::Gemm g{(const bf16_t*)(p.ws + WS_ACT), (const bf16_t*)(p.ws + WS_WDN), M, DM, FF, FF, 0, 256}; pg8::StaticOrder S; S.init(M, DM, G, bx);
        EpiZ E{p.out, p.out}; pg8::gemm_phase<EpiZ>(lds, g, S, E);
    }
    SEAM(9);
    if (IN(10)) { ln_rows(p.out, p.out, nullptr, p.ln2g, p.ln2b, bx * 8 + wave, G * 8, lane); }
#undef IN
#undef SEAM
}

#define REPEAT 0
#ifndef N_LAUNCH_MODE
#define N_LAUNCH_MODE 1
#endif
extern "C" void kernel_launch(void* const* d_in, const int* in_sizes, int n_in, void* d_out, int out_size, void* d_ws, size_t ws_size, hipStream_t stream) {
    static int grid = 0;
    if (grid == 0) {
        if (n_in != 19 || out_size != M * DM || ws_size < WS_END) { fprintf(stderr, "kernel_launch: unexpected shapes (n_in %d out %d ws %zu)\n", n_in, out_size, ws_size); grid = -1; return; }
        int dev = 0, cus = 0, per_cu = 0;
        (void)hipGetDevice(&dev);
        (void)hipDeviceGetAttribute(&cus, hipDeviceAttributeMultiprocessorCount, dev);
        (void)hipFuncSetAttribute((const void*)fwd_kernel, hipFuncAttributeMaxDynamicSharedMemorySize, LDS_BYTES);
        (void)hipOccupancyMaxActiveBlocksPerMultiprocessor(&per_cu, (const void*)fwd_kernel, 512, LDS_BYTES);
        if (per_cu < 1) per_cu = 1;
        grid = cus * per_cu;
        fprintf(stderr, "kernel_launch: grid %d (cus %d x %d)\n", grid, cus, per_cu);
    }
    if (grid < 0) return;
    (void)hipMemsetAsync((char*)d_ws + WS_CTL, 0, 4096, stream);
    Params p{};
    const float** pp = (const float**)&p;
    for (int i = 0; i < 19; ++i) pp[i] = (const float*)d_in[i];
    p.out = (float*)d_out; p.ws = (unsigned char*)d_ws;
#if N_LAUNCH_MODE == 1
    p.ph_lo = 0; p.ph_hi = NPHASE;
    void* args[] = {&p};
    hipError_t e = hipLaunchCooperativeKernel((const void*)fwd_kernel, dim3(grid), dim3(512), args, LDS_BYTES, stream);
    if (e != hipSuccess) fprintf(stderr, "cooperative launch failed: %s (grid %d)\n", hipGetErrorString(e), grid);
#else
    for (int ph = 0; ph < NPHASE; ++ph) { p.ph_lo = ph; p.ph_hi = ph + 1; p.rep = 0; hipLaunchKernelGGL(fwd_kernel, dim3(grid), dim3(512), LDS_BYTES, stream, p);
        if ((REPEAT >> ph) & 1) { p.rep = 1; hipLaunchKernelGGL(fwd_kernel, dim3(grid), dim3(512), LDS_BYTES, stream, p); } }
#endif
}
```

```cpp
#include <hip/hip_runtime.h>
#include <hip/hip_cooperative_groups.h>
#include <cstdio>
#include <cstdint>
namespace cg = cooperative_groups;

#define LAS __attribute__((address_space(3)))
#define DI __device__ __forceinline__
typedef unsigned short bf16_t;
typedef short bf16x8 __attribute__((ext_vector_type(8)));
typedef short s16x4 __attribute__((ext_vector_type(4)));
typedef float f32x4 __attribute__((ext_vector_type(4)));
typedef float f32x16 __attribute__((ext_vector_type(16)));
typedef float f32x2 __attribute__((ext_vector_type(2)));
typedef unsigned u32x4 __attribute__((ext_vector_type(4)));
typedef unsigned u32x2 __attribute__((ext_vector_type(2)));
typedef __bf16 bf16x2_t __attribute__((ext_vector_type(2)));

constexpr int SEQ = 2048, BATCH = 8, DM = 1024, M = BATCH * SEQ;
constexpr int NIN = 5632;
constexpr int FF = 2816, FF2 = 5632;
constexpr float ALPHA = 1.189207115002721f;
constexpr float LOG2E = 1.4426950408889634f;
constexpr int LDS_BYTES = 147456;
constexpr size_t MiB = 1u << 20;
constexpr size_t WS_CTL = 0;
constexpr size_t WS_WIN = 1 * MiB, WS_WUP = 12 * MiB, WS_WDN = 23 * MiB, WS_WO = 29 * MiB, WS_WNSA = 31 * MiB, WS_WGDN = 32 * MiB;
constexpr size_t WS_W1C = 33 * MiB;
constexpr size_t WS_EGL = 33 * MiB + 512 * 1024;
constexpr size_t WS_KVC = 34 * MiB;
constexpr size_t WS_SMALL = 35 * MiB;
constexpr size_t WS_R32 = 37 * MiB;
constexpr size_t WS_H = 69 * MiB;
constexpr size_t WS_HQ = WS_H, WS_HKV = WS_H + 16 * MiB, WS_HG = WS_H + 40 * MiB, WS_HGG = WS_H + 88 * MiB, WS_HM = WS_H + 104 * MiB;
constexpr size_t WS_APERM = WS_H + 168 * MiB;
constexpr size_t WS_MIX = WS_HG;
constexpr size_t WS_ACT = WS_H;
constexpr size_t WS_END = 256 * MiB;
constexpr size_t DO_WNEG = 0, DO_QS = 8u << 20, DO_KST = 16u << 20, DO_UT = 24u << 20;

DI float bf2f(unsigned short u) { return __uint_as_float((unsigned)u << 16); }
DI unsigned pk2(float lo, float hi) { f32x2 v = {lo, hi}; bf16x2_t b = __builtin_convertvector(v, bf16x2_t); return __builtin_bit_cast(unsigned, b); }
DI unsigned short f2bf(float f) { return (unsigned short)(pk2(f, 0.f) & 0xffffu); }
DI float sigmoidf_(float x) { return 1.f / (1.f + __expf(-x)); }
DI float siluf_(float x) { return x / (1.f + __expf(-x)); }
DI float wave_sum(float v) {
#pragma unroll
    for (int o = 1; o < 64; o <<= 1) v += __shfl_xor(v, o);
    return v;
}
DI int lane_id() { return (int)__builtin_amdgcn_mbcnt_hi(~0u, __builtin_amdgcn_mbcnt_lo(~0u, 0u)); }
#define LDS_BARRIER() do { asm volatile("s_waitcnt lgkmcnt(0)" ::: "memory"); __builtin_amdgcn_s_barrier(); asm volatile("" ::: "memory"); } while (0)
DI int crow(int r, int hi) { return (r & 3) + 8 * (r >> 2) + 4 * hi; }
DI int posperm(int x) { return (x & ~31) + ((x >> 2) & 3) * 8 + ((x >> 4) & 1) * 4 + (x & 3); }
#define MFMA16(a, b, c) __builtin_amdgcn_mfma_f32_16x16x32_bf16((a), (b), (c), 0, 0, 0)
#define MFMA32(a, b, c) __builtin_amdgcn_mfma_f32_32x32x16_bf16((a), (b), (c), 0, 0, 0)

namespace pg8 {
constexpr int BM = 256, BK = 64, HALF = 128, HTB = HALF * BK * 2, STAGE_BYTES = 8 * HTB, NXCD = 8, WGM = 8;
__host__ __device__ __forceinline__ int lds_byte(int r, int c) { const int st = (r >> 4) * 2 + (c >> 5), rr = r & 15, cc = c & 31, ob = rr * 64 + cc * 2; return st * 1024 + (ob ^ (((ob >> 9) & 1) << 5)); }
__host__ __device__ __forceinline__ void stage_rc(int b, int& R, int& C) { const int st = b / 1024, sb = b % 1024, swz = sb ^ (((sb >> 9) & 1) << 5); R = (st >> 1) * 16 + swz / 64; C = (st & 1) * 32 + (swz % 64) / 2; }
__host__ __device__ __forceinline__ int perm32(int rho) { const int n = rho >> 4, i = rho & 15; return 8 * (i >> 2) + 4 * n + (i & 3); }
struct Unit { int pm, pn; };
struct Gemm { const bf16_t* A; const bf16_t* Bt; int M, N, K, lda, mrow0, mstep; };
struct StaticOrder {
    int nM, nN, nwg, G, c;
    __host__ __device__ void init(int M_, int N_, int G_, int c_) { nM = M_ / BM; nN = N_ / BM; nwg = nM * nN; G = G_; c = c_; }
    __host__ __device__ void init2(int nM_, int nN_, int G_, int c_) { nM = nM_; nN = nN_; nwg = nM * nN; G = G_; c = c_; }
    __host__ __device__ bool next(int i, Unit& u) const {
        const long L = (long)i * G + c; if (L >= nwg) return false;
        int wgid = (int)L; { const int q = nwg / NXCD, r = nwg % NXCD, xcd = wgid % NXCD, off = wgid / NXCD; wgid = (xcd < r ? xcd * (q + 1) : r * (q + 1) + (xcd - r) * q) + off; }
        const int nig = WGM * nN, gid = wgid / nig, fm = gid * WGM, gsz = (nM - fm) < WGM ? (nM - fm) : WGM;
        u.pm = fm + ((wgid % nig) % gsz); u.pn = (wgid % nig) / gsz; return true;
    }
};
template <class Epi>
__device__ __forceinline__ void gemm_phase(LAS unsigned char* lds, const Gemm g, const StaticOrder& S, const Epi& E, int wave_in) {
    const int wid = wave_in, lane = lane_id(), tid = wid * 64 + lane, wr = wid >> 2, wc = wid & 3, fr = lane & 15, fq = lane >> 4;
    const int K = g.K, nt = K / BK, lda = g.lda;
    unsigned voffA[2], voffB[2];
#pragma unroll
    for (int i = 0; i < 2; ++i) { int R, C; stage_rc(tid * 16 + i * 8192, R, C); const int Rb = Epi::PERM ? ((R & ~31) + perm32(R & 31)) : R;
        voffA[i] = (unsigned)(R * lda + C) * 2u; voffB[i] = (unsigned)(Rb * K + C) * 2u; }
    const size_t kstep = (size_t)(BK * 2);
    const size_t hstepA = (size_t)HALF * lda * 2, hstepB = (size_t)HALF * K * 2;
    const size_t tstepA = (size_t)g.mstep * lda * 2, tstepB = 2 * hstepB;
    const char* const Abase = (const char*)g.A + (ptrdiff_t)g.mrow0 * lda * 2;
    const unsigned ldsw = (unsigned)wid * 1024u;
    const int aoff = lds_byte(wr * 64 + fr, fq * 8), boff = lds_byte(wc * 32 + fr, fq * 8);
#define PG8_SA(b, h) (((b) * 2 + (h)) * HTB)
#define PG8_SB(b, h) ((4 + (b) * 2 + (h)) * HTB)
#define PG8_STAGE(bufoff, gbase, voff) do { _Pragma("unroll") for (int _i = 0; _i < 2; ++_i) \
        __builtin_amdgcn_global_load_lds((const unsigned*)((const char*)(gbase) + (voff)[_i]), (LAS unsigned*)(lds + (bufoff) + ldsw + _i * 8192), 16, 0, 0); } while (0)
#define PG8_LDA(dst, b, h) do { _Pragma("unroll") for (int m = 0; m < 4; ++m) _Pragma("unroll") for (int k = 0; k < 2; ++k) dst[m][k] = *(const LAS bf16x8*)(lds + PG8_SA(b, h) + aoff + m * 2048 + k * 1024); } while (0)
#define PG8_LDB(dst, b, h) do { _Pragma("unroll") for (int n = 0; n < 2; ++n) _Pragma("unroll") for (int k = 0; k < 2; ++k) dst[n][k] = *(const LAS bf16x8*)(lds + PG8_SB(b, h) + boff + n * 2048 + k * 1024); } while (0)
#define PG8_MMA(ai, bj, At, Bt) do { __builtin_amdgcn_s_setprio(1); _Pragma("unroll") for (int m = 0; m < 4; ++m) _Pragma("unroll") for (int n = 0; n < 2; ++n) _Pragma("unroll") for (int k = 0; k < 2; ++k) \
        acc[ai][bj][m][n] = __builtin_amdgcn_mfma_f32_16x16x32_bf16(Bt[n][k], At[m][k], acc[ai][bj][m][n], 0, 0, 0); __builtin_amdgcn_s_setprio(0); } while (0)
#define PG8_WAIT_V(n) asm volatile("s_waitcnt vmcnt(" #n ")" ::: "memory")
#define PG8_WAIT_L(n) asm volatile("s_waitcnt lgkmcnt(" #n ")" ::: "memory")
#define PG8_BAR __builtin_amdgcn_s_barrier()
#define PG8_SCHED __builtin_amdgcn_sched_barrier(0)
    Unit cur, nxt; int ui = 0;
    if (!S.next(0, cur)) return;
    f32x4 acc[2][2][4][2];
#pragma unroll
    for (int a = 0; a < 2; ++a)
#pragma unroll
        for (int b = 0; b < 2; ++b)
#pragma unroll
            for (int m = 0; m < 4; ++m)
#pragma unroll
                for (int n = 0; n < 2; ++n) acc[a][b][m][n] = (f32x4){0.f, 0.f, 0.f, 0.f};
    bf16x8 At[4][2], B0[2][2], B1[2][2];
    const char* cA = Abase + (size_t)cur.pm * tstepA; const char* cB = (const char*)g.Bt + (size_t)cur.pn * tstepB;
    PG8_STAGE(PG8_SB(0, 0), cB, voffB); PG8_STAGE(PG8_SB(0, 1), cB + hstepB, voffB); PG8_STAGE(PG8_SA(0, 0), cA, voffA); PG8_STAGE(PG8_SA(0, 1), cA + hstepA, voffA);
    if (wr == 1) PG8_BAR;
    PG8_WAIT_V(2); PG8_BAR;
    PG8_STAGE(PG8_SB(1, 0), cB + kstep, voffB); PG8_STAGE(PG8_SA(1, 0), cA + kstep, voffA); PG8_STAGE(PG8_SB(1, 1), cB + hstepB + kstep, voffB);
    PG8_WAIT_V(6); PG8_BAR;
    for (;;) {
        const bool has_next = S.next(ui + 1, nxt);
        const char* nA = has_next ? Abase + (size_t)nxt.pm * tstepA : cA; const char* nB = has_next ? (const char*)g.Bt + (size_t)nxt.pn * tstepB : cB;
        for (int t = 0; t < nt; t += 2) {
            const bool last = (t == nt - 2);
            const char* a1 = cA + (size_t)(t + 1) * kstep;
            const char* a2 = last ? nA : cA + (size_t)(t + 2) * kstep; const char* b2 = last ? nB : cB + (size_t)(t + 2) * kstep;
            const char* a3 = a2 + kstep; const char* b3 = b2 + kstep;
            PG8_LDB(B0, 0, 0); PG8_LDB(B1, 0, 1); PG8_SCHED; PG8_LDA(At, 0, 0); PG8_STAGE(PG8_SA(1, 1), a1 + hstepA, voffA);
            PG8_WAIT_V(8); PG8_WAIT_L(0); PG8_BAR; PG8_MMA(0, 0, At, B0); PG8_MMA(0, 1, At, B1); PG8_BAR; PG8_SCHED;
            PG8_LDA(At, 0, 1); PG8_STAGE(PG8_SB(0, 0), b2, voffB); PG8_STAGE(PG8_SB(0, 1), b2 + hstepB, voffB); PG8_STAGE(PG8_SA(0, 0), a2, voffA);
            PG8_WAIT_V(8); PG8_WAIT_L(0); PG8_BAR; PG8_MMA(1, 0, At, B0); PG8_MMA(1, 1, At, B1); PG8_BAR; PG8_SCHED;
            PG8_LDB(B0, 1, 0); PG8_LDB(B1, 1, 1); PG8_SCHED; PG8_LDA(At, 1, 0); PG8_STAGE(PG8_SA(0, 1), a2 + hstepA, voffA);
            PG8_WAIT_V(8); PG8_WAIT_L(0); PG8_BAR; PG8_MMA(0, 0, At, B0); PG8_MMA(0, 1, At, B1); PG8_BAR; PG8_SCHED;
            PG8_LDA(At, 1, 1); PG8_STAGE(PG8_SB(1, 0), b3, voffB); PG8_STAGE(PG8_SB(1, 1), b3 + hstepB, voffB); PG8_STAGE(PG8_SA(1, 0), a3, voffA);
            PG8_WAIT_V(8); PG8_WAIT_L(0); PG8_BAR; PG8_MMA(1, 0, At, B0); PG8_MMA(1, 1, At, B1); PG8_BAR; PG8_SCHED;
        }
        if (wr == 0) PG8_BAR;
        E(acc, cur, wr, wc, fr, fq);
        if (!has_next) break;
#pragma unroll
        for (int a = 0; a < 2; ++a)
#pragma unroll
            for (int b = 0; b < 2; ++b)
#pragma unroll
                for (int m = 0; m < 4; ++m)
#pragma unroll
                    for (int n = 0; n < 2; ++n) acc[a][b][m][n] = (f32x4){0.f, 0.f, 0.f, 0.f};
        cur = nxt; cA = nA; cB = nB; ++ui;
        if (wr == 1) PG8_BAR;
    }
    PG8_WAIT_V(0);
    PG8_BAR;
#undef PG8_SA
#undef PG8_SB
#undef PG8_STAGE
#undef PG8_LDA
#undef PG8_LDB
#undef PG8_MMA
#undef PG8_WAIT_V
#undef PG8_WAIT_L
#undef PG8_BAR
#undef PG8_SCHED
}
}
using pg8::Unit;
typedef f32x4 AccT[2][2][4][2];

DI u32x4 pack8(const f32x4& v0, const f32x4& v1) { u32x4 w; w.x = pk2(v0[0], v0[1]); w.y = pk2(v0[2], v0[3]); w.z = pk2(v1[0], v1[1]); w.w = pk2(v1[2], v1[3]); return w; }
struct EpiH {
    static constexpr bool PERM = true;
    bf16_t *hq, *hkv, *hg, *hgg, *hm; float* small;
    DI void operator()(const AccT& acc, const Unit& u, int wr, int wc, int fr, int fq) const {
        const int pn = u.pn; const int row0 = u.pm * 256 + wr * 64 + fr;
        if (pn == 21) {
            if (wc == 0) {
#pragma unroll
                for (int ai = 0; ai < 2; ++ai)
#pragma unroll
                    for (int m = 0; m < 4; ++m) { float* rp = small + (size_t)(row0 + ai * 128 + m * 16) * 32 + 8 * fq;
                        *(f32x4*)rp = acc[ai][0][m][0]; *(f32x4*)(rp + 4) = acc[ai][0][m][1]; }
            }
            return;
        }
        bf16_t* base; int ldc, ct;
        if (pn < 2) { base = hq; ldc = 512; ct = pn; } else if (pn < 5) { base = hkv; ldc = 768; ct = pn - 2; } else if (pn < 11) { base = hg; ldc = 1536; ct = pn - 5; }
        else if (pn < 13) { base = hgg; ldc = 512; ct = pn - 11; } else { base = hm; ldc = 2048; ct = pn - 13; }
        const int col0 = ct * 256 + wc * 32 + 8 * fq;
#pragma unroll
        for (int ai = 0; ai < 2; ++ai)
#pragma unroll
            for (int m = 0; m < 4; ++m) { bf16_t* rowp = base + (size_t)(row0 + ai * 128 + m * 16) * ldc + col0;
#pragma unroll
                for (int bj = 0; bj < 2; ++bj) *(u32x4*)(rowp + bj * 128) = pack8(acc[ai][bj][m][0], acc[ai][bj][m][1]); }
    }
};
template <int MODE> struct EpiGate {
    static constexpr bool PERM = true;
    const bf16_t* hm; bf16_t* mix;
    DI void operator()(const AccT& acc, const Unit& u, int wr, int wc, int fr, int fq) const {
        const int row0 = u.pm * 256 + wr * 64 + fr, col0 = u.pn * 256 + wc * 32 + 8 * fq;
#pragma unroll
        for (int ai = 0; ai < 2; ++ai)
#pragma unroll
            for (int m = 0; m < 4; ++m) { const size_t row = (size_t)(row0 + ai * 128 + m * 16);
#pragma unroll
                for (int bj = 0; bj < 2; ++bj) { const int col = col0 + bj * 128;
                    const u32x4 gv = *(const u32x4*)(hm + row * 2048 + MODE * 1024 + col);
                    u32x4 old = {0u, 0u, 0u, 0u}; if (MODE == 1) old = *(const u32x4*)(mix + row * 1024 + col);
                    float o[8];
#pragma unroll
                    for (int e = 0; e < 8; ++e) { const unsigned gw = gv[e >> 1], ow = old[e >> 1];
                        const float gg = (e & 1) ? __uint_as_float(gw & 0xffff0000u) : __uint_as_float(gw << 16);
                        const float oo = (e & 1) ? __uint_as_float(ow & 0xffff0000u) : __uint_as_float(ow << 16);
                        const float a = (e < 4) ? acc[ai][bj][m][0][e & 3] : acc[ai][bj][m][1][e & 3];
                        o[e] = sigmoidf_(gg) * a + (MODE == 1 ? oo : 0.f); }
                    u32x4 w; w.x = pk2(o[0], o[1]); w.y = pk2(o[2], o[3]); w.z = pk2(o[4], o[5]); w.w = pk2(o[6], o[7]);
                    *(u32x4*)(mix + row * 1024 + col) = w; } }
    }
};
struct EpiZ {
    static constexpr bool PERM = false;
    const float* base; float* out;
    DI void operator()(const AccT& acc, const Unit& u, int wr, int wc, int fr, int fq) const {
        const int row0 = u.pm * 256 + wr * 64 + fr, col0 = u.pn * 256 + wc * 32 + 4 * fq;
#pragma unroll
        for (int ai = 0; ai < 2; ++ai)
#pragma unroll
            for (int m = 0; m < 4; ++m) { const size_t off = (size_t)(row0 + ai * 128 + m * 16) * 1024 + col0;
#pragma unroll
                for (int bj = 0; bj < 2; ++bj)
#pragma unroll
                    for (int n = 0; n < 2; ++n) { const f32x4 bs = *(const f32x4*)(base + off + bj * 128 + n * 16); *(f32x4*)(out + off + bj * 128 + n * 16) = bs * ALPHA + acc[ai][bj][m][n]; } }
    }
};
DI float dpp_shr1(float oldv, float v) { return __int_as_float(__builtin_amdgcn_update_dpp(__float_as_int(oldv), __float_as_int(v), 0x111, 0xf, 0xf, false)); }
DI float dpp_shr2(float oldv, float v) { return __int_as_float(__builtin_amdgcn_update_dpp(__float_as_int(oldv), __float_as_int(v), 0x112, 0xf, 0xf, false)); }
DI float dpp_ror1(float v) { return __int_as_float(__builtin_amdgcn_update_dpp(0, __float_as_int(v), 0x121, 0xf, 0xf, false)); }
DI float dpp_ror2(float v) { return __int_as_float(__builtin_amdgcn_update_dpp(0, __float_as_int(v), 0x122, 0xf, 0xf, false)); }
struct EpiUpAct {
    static constexpr bool PERM = true;
    bf16_t* act; const float* cw; LAS float* xl;
    DI void operator()(const AccT& acc, const Unit& u, int wr, int wc, int fr_, int fq_) const {
        const int wave = wr * 4 + wc;
        int fr = fr_, fq = fq_; asm volatile("" : "+v"(fr), "+v"(fq));
        if (fr >= 14) {
#pragma unroll
            for (int ai = 0; ai < 2; ++ai)
#pragma unroll
                for (int bj = 0; bj < 2; ++bj)
#pragma unroll
                    for (int n = 0; n < 2; ++n) *(LAS f32x4*)(xl + ((wave * 2 + ai) * 2 + (fr - 14)) * 64 + bj * 32 + fq * 8 + n * 4) = acc[ai][bj][3][n];
        }
        asm volatile("s_waitcnt lgkmcnt(0)" ::: "memory"); __builtin_amdgcn_s_barrier(); asm volatile("" ::: "memory");
        const int colg = 128 * u.pn + 32 * wc + 8 * fq;
#pragma unroll
        for (int n = 0; n < 2; ++n) {
            f32x4 wg[3], wv[3];
#pragma unroll
            for (int j = 0; j < 3; ++j) { wg[j] = *(const f32x4*)(cw + j * FF2 + colg + 4 * n); wv[j] = *(const f32x4*)(cw + j * FF2 + FF + colg + 4 * n); }
#pragma unroll
            for (int ai = 0; ai < 2; ++ai) {
                const bool hasprev = !(ai == 0 && wr == 0);
                const int pw = (wr == 1) ? (wave - 4) : (wave + 4), pai = (wr == 1) ? ai : (ai - 1);
#pragma unroll
                for (int m = 0; m < 4; ++m) {
                    const int r = 128 * ai + 64 * wr + 16 * m + fr; const int grow = 254 * u.pm - 2 + r; const int sp = grow & 2047;
                    float o[4];
                    const LAS float* b15 = xl + ((pw * 2 + pai) * 2 + 1) * 64 + fq * 8 + n * 4;
                    const LAS float* b2 = xl + ((pw * 2 + pai) * 2 + (fr == 0 ? 0 : 1)) * 64 + fq * 8 + n * 4;
#pragma unroll
                    for (int e = 0; e < 4; ++e) {
                        float o1g, o2g, o1v, o2v;
                        if (m == 0) {
                            if (hasprev) { o1g = b15[e]; o1v = b15[32 + e]; o2g = b2[e]; o2v = b2[32 + e]; }
                            else { o1g = 0.f; o1v = 0.f; o2g = 0.f; o2v = 0.f; }
                        } else {
                            const float pg = acc[ai][0][m > 0 ? m - 1 : 0][n][e], pv = acc[ai][1][m > 0 ? m - 1 : 0][n][e];
                            o1g = dpp_ror1(pg); o2g = dpp_ror2(pg); o1v = dpp_ror1(pv); o2v = dpp_ror2(pv);
                        }
                        const float g0 = acc[ai][0][m][n][e], v0 = acc[ai][1][m][n][e];
                        float g1 = dpp_shr1(o1g, g0), g2 = dpp_shr2(o2g, g0), v1 = dpp_shr1(o1v, v0), v2 = dpp_shr2(o2v, v0);
                        if (sp < 1) { g1 = 0.f; v1 = 0.f; }
                        if (sp < 2) { g2 = 0.f; v2 = 0.f; }
                        const float gg = wg[0][e] * g2 + wg[1][e] * g1 + wg[2][e] * g0, vv = wv[0][e] * v2 + wv[1][e] * v1 + wv[2][e] * v0;
                        o[e] = siluf_(gg) * vv;
                    }
                    if (r >= 2 && grow < M) { u32x2 w; w.x = pk2(o[0], o[1]); w.y = pk2(o[2], o[3]); *(u32x2*)(act + (size_t)grow * FF + colg + 4 * n) = w; }
                    asm volatile("" ::: "memory");
                }
            }
        }
    }
};

struct Params {
    const float *x, *w_in, *cmp_pos, *cmp_w1, *cmp_w2, *w_nsa, *gdn_conv, *a_log, *dt_bias, *norm_w, *w_gdn, *w_o, *ln1g, *ln1b, *w_up, *ffn_conv, *w_dn, *ln2g, *ln2b;
    float* out; unsigned char* ws; int ph_lo, ph_hi, rep, pad;
};

DI void tr_item(const float* W, int K, int Nsrc, int c0, int width, bf16_t* WT, int r0, LAS float* scr, int item, int lane) {
    const int nblk = (width + 31) >> 5, kb = item / nblk, nb = item - kb * nblk, k0 = 64 * kb, n0 = 32 * nb;
    const int n4 = (lane & 7) * 4; const bool cin = (n0 + n4) < width;
    f32x4 v[8];
#pragma unroll
    for (int i = 0; i < 8; ++i) { const int kk = (lane >> 3) + 8 * i; v[i] = cin ? *(const f32x4*)(W + (size_t)(k0 + kk) * Nsrc + c0 + n0 + n4) : (f32x4){0.f, 0.f, 0.f, 0.f}; }
#pragma unroll
    for (int i = 0; i < 8; ++i) { const int kk = (lane >> 3) + 8 * i;
#pragma unroll
        for (int e = 0; e < 4; ++e) scr[kk * 33 + n4 + e] = v[i][e]; }
    asm volatile("s_waitcnt lgkmcnt(0)" ::: "memory");
    const int c = lane & 7;
#pragma unroll
    for (int j = 0; j < 4; ++j) { const int n = (lane >> 3) + 8 * j; const LAS float* sp = scr + (8 * c) * 33 + n;
        u32x4 o; o.x = pk2(sp[0 * 33], sp[1 * 33]); o.y = pk2(sp[2 * 33], sp[3 * 33]); o.z = pk2(sp[4 * 33], sp[5 * 33]); o.w = pk2(sp[6 * 33], sp[7 * 33]);
        if (n0 + n < width) *(u32x4*)(WT + (size_t)(r0 + n0 + n) * K + k0 + 8 * c) = o; }
    asm volatile("s_waitcnt lgkmcnt(0)" ::: "memory");
}
DI void p0_prologue(const Params& p, LAS unsigned char* lds, int wave, int lane) {
    LAS float* scr = (LAS float*)(lds + wave * 16384);
    const int gw = blockIdx.x * 8 + wave, NGW = gridDim.x * 8;
    bf16_t* win = (bf16_t*)(p.ws + WS_WIN);
    constexpr int TOTAL = 16 * 171 + 16 * 176 + 44 * 32 + 16 * 32 + 8 * 32 + 8 * 32 + 2 * 32 * 2;
#define SEG(W, K, NS, C0, WD, WT, R0) { const int ni = ((K) / 64) * (((WD) + 31) / 32); if (r < ni) { tr_item(W, K, NS, C0, WD, WT, R0, scr, r, lane); continue; } r -= ni; }
    for (int it = gw; it < TOTAL; it += NGW) {
        int r = it;
        SEG(p.w_in, 1024, 5408, 0, 512, win, 0)
        SEG(p.w_in, 1024, 5408, 512, 768, win, 512)
        SEG(p.w_in, 1024, 5408, 1304, 1536, win, 1280)
        SEG(p.w_in, 1024, 5408, 2848, 512, win, 2816)
        SEG(p.w_in, 1024, 5408, 3360, 2048, win, 3328)
        SEG(p.w_in, 1024, 5408, 1280, 24, win, 5376)
        SEG(p.w_in, 1024, 5408, 2840, 4, win, 5400)
        SEG(p.w_in, 1024, 5408, 2844, 4, win, 5404)
        { const int ni = 16 * 4 * 44; if (r < ni) { const int seg = r >> 6; tr_item(p.w_up, 1024, 5632, (seg & 1) * 2816 + 128 * (seg >> 1), 128, (bf16_t*)(p.ws + WS_WUP), 128 * seg, scr, r & 63, lane); continue; } r -= ni; }
        SEG(p.w_dn, 2816, 1024, 0, 1024, (bf16_t*)(p.ws + WS_WDN), 0)
        SEG(p.w_o, 1024, 1024, 0, 1024, (bf16_t*)(p.ws + WS_WO), 0)
        SEG(p.w_nsa, 512, 1024, 0, 1024, (bf16_t*)(p.ws + WS_WNSA), 0)
        SEG(p.w_gdn, 512, 1024, 0, 1024, (bf16_t*)(p.ws + WS_WGDN), 0)
        SEG(p.cmp_w1, 2048, 64, 0, 64, (bf16_t*)(p.ws + WS_W1C), 0)
        SEG(p.cmp_w1 + 2048 * 64, 2048, 64, 0, 64, (bf16_t*)(p.ws + WS_W1C) + 64 * 2048, 0)
    }
#undef SEG
    const int gtid = blockIdx.x * 512 + wave * 64 + lane, gsz = gridDim.x * 512;
    for (int i = gtid; i < 224 * 1024 / 8; i += gsz) *(u32x4*)(win + (size_t)5408 * 1024 + (size_t)i * 8) = (u32x4){0u, 0u, 0u, 0u};
    bf16_t* xb = (bf16_t*)(p.ws + WS_R32);
    for (int i = gtid; i < M * DM / 8; i += gsz) { const f32x4 a = *(const f32x4*)(p.x + (size_t)i * 8), b = *(const f32x4*)(p.x + (size_t)i * 8 + 4); *(u32x4*)(xb + (size_t)i * 8) = pack8(a, b); }
}

DI void cmp_task(const Params& p, LAS unsigned char* lds, int task, int wave, int lane) {
    const int rt = task & 7, g = (task >> 3) & 1, b = (task >> 4) & 7, i = task >> 7;
    const bf16_t* hkv = (const bf16_t*)(p.ws + WS_HKV);
    const bf16_t* w1t = (const bf16_t*)(p.ws + WS_W1C) + (size_t)i * 64 * 2048;
    const float* pos = p.cmp_pos + i * 2048;
    LAS float* red = (LAS float*)lds;
    LAS float* gl = (LAS float*)(lds + 32768);
    const int row = lane & 15, quad = lane >> 4;
    int n = 16 * rt + row; if (n > 126) n = 126;
    f32x4 acc[4];
#pragma unroll
    for (int nt = 0; nt < 4; ++nt) acc[nt] = (f32x4){0.f, 0.f, 0.f, 0.f};
#pragma unroll
    for (int ks = 0; ks < 8; ++ks) {
        const int l = 4 * wave + (ks >> 1), d = (ks & 1) * 32 + quad * 8;
        const u32x4 raw = *(const u32x4*)(hkv + (size_t)(b * SEQ + 16 * n + l) * 768 + i * 128 + g * 64 + d);
        const f32x4 p0 = *(const f32x4*)(pos + l * 64 + d), p1 = *(const f32x4*)(pos + l * 64 + d + 4);
        float v[8];
#pragma unroll
        for (int e = 0; e < 8; ++e) { const unsigned w = raw[e >> 1]; v[e] = ((e & 1) ? __uint_as_float(w & 0xffff0000u) : __uint_as_float(w << 16)) + (e < 4 ? p0[e & 3] : p1[e & 3]); }
        u32x4 aw; aw.x = pk2(v[0], v[1]); aw.y = pk2(v[2], v[3]); aw.z = pk2(v[4], v[5]); aw.w = pk2(v[6], v[7]);
        const bf16x8 a = __builtin_bit_cast(bf16x8, aw);
        const int k = wave * 256 + ks * 32 + quad * 8;
#pragma unroll
        for (int nt = 0; nt < 4; ++nt) { const bf16x8 bb = *(const bf16x8*)(w1t + (size_t)(nt * 16 + row) * 2048 + k); acc[nt] = MFMA16(a, bb, acc[nt]); }
    }
#pragma unroll
    for (int nt = 0; nt < 4; ++nt)
#pragma unroll
        for (int jj = 0; jj < 4; ++jj) red[(wave * 16 + quad * 4 + jj) * 64 + nt * 16 + row] = acc[nt][jj];
    __syncthreads();
    const int tid = wave * 64 + lane;
#pragma unroll
    for (int e = 0; e < 2; ++e) { const int o = tid + 512 * e; float s = 0.f;
#pragma unroll
        for (int w = 0; w < 8; ++w) s += red[w * 1024 + o];
        const float u = 0.7978845608028654f * (s + 0.044715f * s * s * s);
        gl[o] = 0.5f * s * (1.f + tanhf(u)); }
    __syncthreads();
    const float* w2 = p.cmp_w2 + i * 4096;
    float* kvc = (float*)(p.ws + WS_KVC) + (size_t)((i * 16 + b * 2 + g) * 128) * 64;
#pragma unroll
    for (int e = 0; e < 2; ++e) { const int o = tid + 512 * e, r = o >> 6, j = o & 63; float s = 0.f;
#pragma unroll 8
        for (int k = 0; k < 64; ++k) s += gl[r * 64 + k] * w2[k * 64 + j];
        const int nn = 16 * rt + r; kvc[(size_t)nn * 64 + j] = (nn <= 126) ? s : 0.f; }
    __syncthreads();
}

constexpr int GP_KB = 0, GP_QB = 17408, GP_VBT = 34816, GP_KGT = 53248, GP_KSTL = 71680, GP_MM = 90112, GP_TB = 107520, GP_MISC = 116736;
DI void unpack8(const u32x4& w, float* f) {
#pragma unroll
    for (int e = 0; e < 8; ++e) f[e] = (e & 1) ? __uint_as_float(w[e >> 1] & 0xffff0000u) : __uint_as_float(w[e >> 1] << 16);
}
DI void gdn_prep_task(const Params& p, LAS unsigned char* lds, int task, int wave, int lane) {
    const int tid = wave * 64 + lane;
    const int n = task & 31, h = (task >> 5) & 3, b = task >> 7;
    const int rowb = b * SEQ + n * 64;
    const bf16_t* hg = (const bf16_t*)(p.ws + WS_HG);
    const float* small = (const float*)(p.ws + WS_SMALL);
    LAS bf16_t* KB = (LAS bf16_t*)(lds + GP_KB); LAS bf16_t* QB = (LAS bf16_t*)(lds + GP_QB);
    LAS bf16_t* VBT = (LAS bf16_t*)(lds + GP_VBT); LAS bf16_t* KGT = (LAS bf16_t*)(lds + GP_KGT); LAS bf16_t* KSTL = (LAS bf16_t*)(lds + GP_KSTL);
    LAS float* betaL = (LAS float*)(lds + GP_MISC); LAS float* gcL = betaL + 64;
    LAS float* MMf = (LAS float*)(lds + GP_MM); LAS bf16_t* TB = (LAS bf16_t*)(lds + GP_TB);
    bf16_t* dob = (bf16_t*)p.out;
    bf16_t* wneg_g = dob + DO_WNEG + (size_t)task * 8192; bf16_t* qs_g = dob + DO_QS + (size_t)task * 8192;
    bf16_t* kst_g = dob + DO_KST + (size_t)task * 8192; bf16_t* ut_g = dob + DO_UT + (size_t)task * 8192;
    bf16_t* ap_g = (bf16_t*)(p.ws + WS_APERM) + (size_t)task * 4096;
    if (wave == 0) {
        const float braw = small[(size_t)(rowb + lane) * 32 + 24 + h], draw = small[(size_t)(rowb + lane) * 32 + 28 + h];
        const float z = draw + p.dt_bias[h];
        const float sp = fmaxf(z, 0.f) + log1pf(__expf(-fabsf(z)));
        float gc = -__expf(p.a_log[h]) * sp;
#pragma unroll
        for (int o = 1; o < 64; o <<= 1) { const float t = __shfl_up(gc, o); if (lane >= o) gc += t; }
        betaL[lane] = sigmoidf_(braw); gcL[lane] = gc;
        if (lane == 63) ((float*)(p.ws + WS_EGL))[task] = __expf(gc);
    }
    __syncthreads();
    {
        const int t = tid >> 3, c16 = tid & 7, ts = n * 64 + t;
        const float bt = betaL[t], gct = gcL[t], glast = gcL[63];
        const float eg = __expf(gct), egl = __expf(glast - gct);
#pragma unroll 1
        for (int mat = 0; mat < 3; ++mat) {
            const int gcol = mat * 512 + h * 128 + c16 * 16;
            const bf16_t* src = hg + (size_t)(b * SEQ) * 1536 + gcol;
            float y[16];
#pragma unroll
            for (int e = 0; e < 16; ++e) y[e] = 0.f;
#pragma unroll
            for (int j = 0; j < 4; ++j) {
                const int tt = ts - 3 + j;
                u32x4 r0 = {0u, 0u, 0u, 0u}, r1 = {0u, 0u, 0u, 0u};
                if (tt >= 0) { r0 = *(const u32x4*)(src + (size_t)tt * 1536); r1 = *(const u32x4*)(src + (size_t)tt * 1536 + 8); }
                float x[16]; unpack8(r0, x); unpack8(r1, x + 8);
#pragma unroll
                for (int q4 = 0; q4 < 4; ++q4) { const f32x4 w = *(const f32x4*)(p.gdn_conv + j * 1536 + gcol + 4 * q4);
#pragma unroll
                    for (int e = 0; e < 4; ++e) y[4 * q4 + e] += w[e] * x[4 * q4 + e]; }
            }
            float ss = 0.f;
#pragma unroll
            for (int e = 0; e < 16; ++e) { y[e] = siluf_(y[e]); ss += y[e] * y[e]; }
            ss += __shfl_xor(ss, 1); ss += __shfl_xor(ss, 2); ss += __shfl_xor(ss, 4);
            const float rs = rsqrtf(ss + 1e-6f);
            if (mat == 0) {
                const float sc = rs * 0.08838834764831845f;
                float qn[16];
#pragma unroll
                for (int e = 0; e < 16; ++e) qn[e] = y[e] * sc;
                u32x4 w0, w1; w0.x = pk2(qn[0], qn[1]); w0.y = pk2(qn[2], qn[3]); w0.z = pk2(qn[4], qn[5]); w0.w = pk2(qn[6], qn[7]); w1.x = pk2(qn[8], qn[9]); w1.y = pk2(qn[10], qn[11]); w1.z = pk2(qn[12], qn[13]); w1.w = pk2(qn[14], qn[15]);
                *(LAS u32x4*)(QB + t * 136 + c16 * 16) = w0; *(LAS u32x4*)(QB + t * 136 + c16 * 16 + 8) = w1;
#pragma unroll
                for (int q4 = 0; q4 < 4; ++q4) { u32x2 w; w.x = pk2(qn[4 * q4] * eg, qn[4 * q4 + 1] * eg); w.y = pk2(qn[4 * q4 + 2] * eg, qn[4 * q4 + 3] * eg);
                    *(u32x2*)(qs_g + t * 128 + 32 * (c16 >> 1) + 8 * q4 + 4 * (c16 & 1)) = w; }
            } else if (mat == 1) {
                float kn[16];
#pragma unroll
                for (int e = 0; e < 16; ++e) kn[e] = y[e] * rs;
                u32x4 w0, w1; w0.x = pk2(kn[0], kn[1]); w0.y = pk2(kn[2], kn[3]); w0.z = pk2(kn[4], kn[5]); w0.w = pk2(kn[6], kn[7]); w1.x = pk2(kn[8], kn[9]); w1.y = pk2(kn[10], kn[11]); w1.z = pk2(kn[12], kn[13]); w1.w = pk2(kn[14], kn[15]);
                *(LAS u32x4*)(KB + t * 136 + c16 * 16) = w0; *(LAS u32x4*)(KB + t * 136 + c16 * 16 + 8) = w1;
                const float f1 = bt * eg; const int pt = posperm(t);
#pragma unroll
                for (int e = 0; e < 16; ++e) { KGT[(c16 * 16 + e) * 72 + t] = f2bf(kn[e] * f1); KSTL[(c16 * 16 + e) * 72 + pt] = f2bf(kn[e] * egl); }
            } else {
#pragma unroll
                for (int e = 0; e < 16; ++e) VBT[(c16 * 16 + e) * 72 + t] = f2bf(y[e] * bt);
            }
        }
    }
    __syncthreads();
    { const int row = lane & 15, quad = lane >> 4;
#pragma unroll
      for (int jb = 0; jb < 2; ++jb) { const int tt = wave * 2 + jb, ti = tt >> 2, tj = tt & 3;
        f32x4 ak = {0.f, 0.f, 0.f, 0.f}, aq = {0.f, 0.f, 0.f, 0.f};
        if (tj <= ti) {
#pragma unroll
            for (int pp = 0; pp < 4; ++pp) { const bf16x8 bk = *(const LAS bf16x8*)(KB + (16 * tj + row) * 136 + 32 * pp + 8 * quad);
                const bf16x8 a_k = *(const LAS bf16x8*)(KB + (16 * ti + row) * 136 + 32 * pp + 8 * quad), a_q = *(const LAS bf16x8*)(QB + (16 * ti + row) * 136 + 32 * pp + 8 * quad);
                ak = MFMA16(a_k, bk, ak); aq = MFMA16(a_q, bk, aq); } }
        const int j = 16 * tj + row; const float gj = gcL[j];
#pragma unroll
        for (int jj = 0; jj < 4; ++jj) { const int i = 16 * ti + 4 * quad + jj; const float dec = __expf(fminf(gcL[i] - gj, 0.f));
            MMf[i * 68 + j] = (j < i) ? betaL[i] * ak[jj] * dec : 0.f;
            ap_g[i * 64 + posperm(j)] = f2bf((j <= i) ? aq[jj] * dec : 0.f); } }
#pragma unroll
      for (int e = 0; e < 2; ++e) { const int pc = tid + 512 * e, d = pc >> 3, c8 = (pc & 7) * 8; *(u32x4*)(kst_g + d * 64 + c8) = *(const LAS u32x4*)(KSTL + d * 72 + c8); } }
    __syncthreads();
    if (wave == 0) {
        float t[64];
        unsigned mb = GP_MM; asm volatile("" : "+v"(mb));
        const LAS float* MMv = (const LAS float*)(lds + mb);
#pragma unroll
        for (int i = 0; i < 64; ++i) {
            float a0 = (i == lane) ? 1.f : 0.f, a1 = 0.f, a2 = 0.f, a3 = 0.f;
#pragma unroll
            for (int j4 = 0; j4 < (i + 3) / 4; ++j4) { const f32x4 m4 = *(const LAS f32x4*)(MMv + i * 68 + 4 * j4);
                if (4 * j4 + 0 < i) a0 -= m4[0] * t[4 * j4 + 0];
                if (4 * j4 + 1 < i) a1 -= m4[1] * t[4 * j4 + 1];
                if (4 * j4 + 2 < i) a2 -= m4[2] * t[4 * j4 + 2];
                if (4 * j4 + 3 < i) a3 -= m4[3] * t[4 * j4 + 3]; }
            t[i] = (a0 + a1) + (a2 + a3);
        }
        asm volatile("s_waitcnt lgkmcnt(0)" ::: "memory");
#pragma unroll
        for (int i = 0; i < 64; ++i) TB[i * 72 + lane] = f2bf(t[i]);
    }
    __syncthreads();
    { const int row = lane & 15, quad = lane >> 4;
      f32x4 au[4], aw[4];
#pragma unroll
      for (int i = 0; i < 4; ++i) { au[i] = (f32x4){0.f, 0.f, 0.f, 0.f}; aw[i] = (f32x4){0.f, 0.f, 0.f, 0.f}; }
#pragma unroll
      for (int pp = 0; pp < 2; ++pp) {
          const bf16x8 bv = *(const LAS bf16x8*)(VBT + (16 * wave + row) * 72 + 32 * pp + 8 * quad);
          const bf16x8 akg = *(const LAS bf16x8*)(KGT + (16 * wave + row) * 72 + 32 * pp + 8 * quad);
#pragma unroll
          for (int i = 0; i < 4; ++i) { const bf16x8 tb = *(const LAS bf16x8*)(TB + (16 * i + row) * 72 + 32 * pp + 8 * quad);
              au[i] = MFMA16(tb, bv, au[i]);
              aw[i] = MFMA16(akg, tb, aw[i]); }
      }
#pragma unroll
      for (int i = 0; i < 4; ++i) {
          u32x2 uw; uw.x = pk2(au[i][0], au[i][1]); uw.y = pk2(au[i][2], au[i][3]);
          *(u32x2*)(ut_g + (16 * wave + row) * 64 + 16 * i + 4 * quad) = uw;
          u32x2 ww; ww.x = pk2(-aw[i][0], -aw[i][1]); ww.y = pk2(-aw[i][2], -aw[i][3]);
          *(u32x2*)(wneg_g + (16 * i + row) * 128 + 32 * (wave >> 1) + 8 * quad + 4 * (wave & 1)) = ww; } }
    __syncthreads();
}

constexpr int GS_BUF = 62464, GS_QS = 17408, GS_A = 34816, GS_KST = 44032, GS_PART = 2 * GS_BUF;
DI void gdn_scan(const Params& p, LAS unsigned char* lds, int bh, int wave, int lane) {
    const int tid = wave * 64 + lane, b = bh >> 2, h = bh & 3;
    const bf16_t* dob = (const bf16_t*)p.out;
    const bf16_t* hgg = (const bf16_t*)(p.ws + WS_HGG);
    const float* egl = (const float*)(p.ws + WS_EGL) + bh * 32;
    bf16_t* gdn_o = (bf16_t*)(p.ws + WS_R32) + (size_t)M * 512;
    LAS float* part = (LAS float*)(lds + GS_PART);
    const int col = lane & 15, quad = lane >> 4, n0 = 16 * wave;
    unsigned goff[7], loff[7];
#pragma unroll
    for (int k = 0; k < 7; ++k) { const int pc = tid + 512 * k;
        if (k < 2) { goff[k] = (unsigned)(DO_WNEG) + pc * 8; loff[k] = (pc >> 4) * 272 + (pc & 15) * 16; }
        else if (k < 4) { const int q = pc - 1024; goff[k] = (unsigned)(DO_QS) + q * 8; loff[k] = GS_QS + (q >> 4) * 272 + (q & 15) * 16; }
        else if (k < 5) { const int q = pc - 2048; goff[k] = 0xffffffffu; loff[k] = GS_A + (q >> 3) * 144 + (q & 7) * 16; }
        else { const int q = pc - 2560; goff[k] = (unsigned)(DO_KST) + q * 8; loff[k] = GS_KST + (q >> 3) * 144 + (q & 7) * 16; } }
    const bf16_t* ap_base = (const bf16_t*)(p.ws + WS_APERM);
    u32x4 stg[7];
#define GS_LOAD(ch) do { const size_t cb = (size_t)(ch) * 8192; _Pragma("unroll") for (int k = 0; k < 7; ++k) { \
        if (k == 4) stg[k] = *(const u32x4*)(ap_base + (size_t)(ch) * 4096 + (tid + 512 * 4 - 2048) * 8); else stg[k] = *(const u32x4*)(dob + cb + goff[k]); } } while (0)
#define GS_STORE(bufi) do { _Pragma("unroll") for (int k = 0; k < 7; ++k) *(LAS u32x4*)(lds + (bufi) * GS_BUF + loff[k]) = stg[k]; } while (0)
    f32x4 S[8];
#pragma unroll
    for (int t = 0; t < 8; ++t) S[t] = (f32x4){0.f, 0.f, 0.f, 0.f};
    const int ch0 = bh * 32;
    GS_LOAD(ch0); GS_STORE(0);
    u32x2 uraw[4]; float eg;
#define GS_SMALL(nn) do { const bf16_t* utp_ = dob + DO_UT + (size_t)(ch0 + (nn)) * 8192 + (n0 + col) * 64 + 4 * quad; \
        _Pragma("unroll") for (int i = 0; i < 4; ++i) uraw[i] = *(const u32x2*)(utp_ + 16 * i); \
        eg = egl[(nn)]; } while (0)
    GS_SMALL(0);
    float* oraw = (float*)(p.ws + WS_HG) + (size_t)bh * (SEQ * 128);
    LDS_BARRIER();
    for (int n = 0; n < 32; ++n) {
        const int nn = (n + 1 < 32) ? n + 1 : 31;
        GS_LOAD(ch0 + nn);
        const LAS unsigned char* buf = lds + (n & 1) * GS_BUF;
        f32x4 V[4], O[4];
        const float egc = eg;
#pragma unroll
        for (int i = 0; i < 4; ++i) { V[i] = (f32x4){__uint_as_float(uraw[i].x << 16), __uint_as_float(uraw[i].x & 0xffff0000u), __uint_as_float(uraw[i].y << 16), __uint_as_float(uraw[i].y & 0xffff0000u)};
            O[i] = (f32x4){0.f, 0.f, 0.f, 0.f}; }
        GS_SMALL(nn);
        bf16x8 Sop[4];
#pragma unroll
        for (int pp = 0; pp < 4; ++pp) { u32x4 w; w.x = pk2(S[2 * pp][0], S[2 * pp][1]); w.y = pk2(S[2 * pp][2], S[2 * pp][3]); w.z = pk2(S[2 * pp + 1][0], S[2 * pp + 1][1]); w.w = pk2(S[2 * pp + 1][2], S[2 * pp + 1][3]); Sop[pp] = __builtin_bit_cast(bf16x8, w); }
#pragma unroll
        for (int i = 0; i < 4; ++i)
#pragma unroll
            for (int pp = 0; pp < 4; ++pp) { const bf16x8 aw = *(const LAS bf16x8*)(buf + (16 * i + col) * 272 + (32 * pp + 8 * quad) * 2);
                const bf16x8 aq = *(const LAS bf16x8*)(buf + GS_QS + (16 * i + col) * 272 + (32 * pp + 8 * quad) * 2);
                V[i] = MFMA16(aw, Sop[pp], V[i]); O[i] = MFMA16(aq, Sop[pp], O[i]); }
        bf16x8 Vop[2];
#pragma unroll
        for (int pp = 0; pp < 2; ++pp) { u32x4 w; w.x = pk2(V[2 * pp][0], V[2 * pp][1]); w.y = pk2(V[2 * pp][2], V[2 * pp][3]); w.z = pk2(V[2 * pp + 1][0], V[2 * pp + 1][1]); w.w = pk2(V[2 * pp + 1][2], V[2 * pp + 1][3]); Vop[pp] = __builtin_bit_cast(bf16x8, w); }
#pragma unroll
        for (int i = 0; i < 4; ++i)
#pragma unroll
            for (int pp = 0; pp < 2; ++pp) { const bf16x8 aa = *(const LAS bf16x8*)(buf + GS_A + (16 * i + col) * 144 + (32 * pp + 8 * quad) * 2); O[i] = MFMA16(aa, Vop[pp], O[i]); }
#pragma unroll
        for (int t = 0; t < 8; ++t) { S[t] = S[t] * egc;
#pragma unroll
            for (int pp = 0; pp < 2; ++pp) { const bf16x8 ak = *(const LAS bf16x8*)(buf + GS_KST + (16 * t + col) * 144 + (32 * pp + 8 * quad) * 2); S[t] = MFMA16(ak, Vop[pp], S[t]); } }
        { float* op = oraw + (size_t)(n * 64 + 4 * quad) * 128 + n0 + col;
#pragma unroll
          for (int i = 0; i < 4; ++i)
#pragma unroll
              for (int jj = 0; jj < 4; ++jj) op[(16 * i + jj) * 128] = O[i][jj]; }
        GS_STORE((n + 1) & 1);
        LDS_BARRIER();
    }
#undef GS_SMALL
    __threadfence(); __syncthreads();
    { const int sub = lane & 15, rq = lane >> 4;
      const f32x4 nw0 = *(const f32x4*)(p.norm_w + 8 * sub), nw1 = *(const f32x4*)(p.norm_w + 8 * sub + 4);
#pragma unroll 2
      for (int it = 0; it < 64; ++it) { const int r = it * 32 + wave * 4 + rq;
          const f32x4 a0 = *(const f32x4*)(oraw + (size_t)r * 128 + 8 * sub), a1 = *(const f32x4*)(oraw + (size_t)r * 128 + 8 * sub + 4);
          const u32x4 gr = *(const u32x4*)(hgg + ((size_t)b * SEQ + r) * 512 + h * 128 + 8 * sub);
          float sq = (a0[0] * a0[0] + a0[1] * a0[1]) + (a0[2] * a0[2] + a0[3] * a0[3]) + (a1[0] * a1[0] + a1[1] * a1[1]) + (a1[2] * a1[2] + a1[3] * a1[3]);
          sq += __shfl_xor(sq, 1); sq += __shfl_xor(sq, 2); sq += __shfl_xor(sq, 4); sq += __shfl_xor(sq, 8);
          const float rstd = rsqrtf(sq * (1.f / 128.f) + 1e-6f);
          float gt[8]; unpack8(gr, gt);
          float o[8];
#pragma unroll
          for (int e = 0; e < 4; ++e) { o[e] = a0[e] * rstd * nw0[e] * siluf_(gt[e]); o[4 + e] = a1[e] * rstd * nw1[e] * siluf_(gt[4 + e]); }
          u32x4 w; w.x = pk2(o[0], o[1]); w.y = pk2(o[2], o[3]); w.z = pk2(o[4], o[5]); w.w = pk2(o[6], o[7]);
          *(u32x4*)(gdn_o + ((size_t)b * SEQ + r) * 512 + h * 128 + 8 * sub) = w; } }
#undef GS_LOAD
#undef GS_STORE
}

constexpr int NA_KS = 0, NA_VT = 18432, NA_PS = 36864, NA_SELM = 70656, NA_UNI = 70912, NA_Q = 71168, NA_OACC = 71680;
constexpr int NA_TILE = 9216;
struct NsaState { float m, l; f32x16 o0, o1; };
template <int MODE>
DI void nsa_tile(LAS unsigned char* lds, int bufi, const bf16x8 (&qf)[4], NsaState& st, int kbase, int t, int hi, int lane, float c1, float slope2, bool sel) {
    const LAS bf16_t* KS = (const LAS bf16_t*)(lds + NA_KS + bufi * NA_TILE);
    const LAS bf16_t* VT = (const LAS bf16_t*)(lds + NA_VT + bufi * NA_TILE);
    const int ql = lane & 31;
    f32x16 s0, s1;
#pragma unroll
    for (int r = 0; r < 16; ++r) { s0[r] = 0.f; s1[r] = 0.f; }
#pragma unroll
    for (int kk = 0; kk < 4; ++kk) {
        const bf16x8 a0 = *(const LAS bf16x8*)(KS + ql * 72 + 16 * kk + 8 * hi), a1 = *(const LAS bf16x8*)(KS + (32 + ql) * 72 + 16 * kk + 8 * hi);
        s0 = MFMA32(a0, qf[kk], s0); s1 = MFMA32(a1, qf[kk], s1);
    }
    asm volatile("" ::: "memory");
    float sl = slope2; asm volatile("" : "+v"(sl));
    const int dq = t - 4 * hi - kbase;
    const float base = -sl * (float)dq;
    float mx = -INFINITY;
#pragma unroll
    for (int r = 0; r < 16; ++r) {
        const int c0 = (r & 3) + 8 * (r >> 2), c1k = 32 + c0;
        bool v0 = sel && dq >= c0, v1 = sel && dq >= c1k;
        if (MODE == 1) { v0 = v0 && dq < 512 + c0; v1 = v1 && dq < 512 + c1k; }
        s0[r] = v0 ? (s0[r] * c1 + (base + sl * (float)c0)) : -INFINITY;
        s1[r] = v1 ? (s1[r] * c1 + (base + sl * (float)c1k)) : -INFINITY;
        mx = fmaxf(mx, fmaxf(s0[r], s1[r]));
    }
    mx = fmaxf(mx, __shfl_xor(mx, 32));
    const float mnew = fmaxf(st.m, mx);
    const float al = __builtin_amdgcn_exp2f(st.m - mnew);
    float rs = 0.f;
#pragma unroll
    for (int r = 0; r < 16; ++r) { s0[r] = __builtin_amdgcn_exp2f(s0[r] - mnew); s1[r] = __builtin_amdgcn_exp2f(s1[r] - mnew); rs += s0[r] + s1[r]; }
    rs += __shfl_xor(rs, 32);
    st.l = st.l * al + rs; st.m = mnew;
#pragma unroll
    for (int r = 0; r < 16; ++r) { st.o0[r] *= al; st.o1[r] *= al; }
#pragma unroll
    for (int sub = 0; sub < 2; ++sub)
#pragma unroll
        for (int u = 0; u < 2; ++u) {
            u32x4 pw;
            if (sub == 0) { pw.x = pk2(s0[8 * u], s0[8 * u + 1]); pw.y = pk2(s0[8 * u + 2], s0[8 * u + 3]); pw.z = pk2(s0[8 * u + 4], s0[8 * u + 5]); pw.w = pk2(s0[8 * u + 6], s0[8 * u + 7]); }
            else { pw.x = pk2(s1[8 * u], s1[8 * u + 1]); pw.y = pk2(s1[8 * u + 2], s1[8 * u + 3]); pw.z = pk2(s1[8 * u + 4], s1[8 * u + 5]); pw.w = pk2(s1[8 * u + 6], s1[8 * u + 7]); }
            const bf16x8 pb = __builtin_bit_cast(bf16x8, pw);
            const int kc = 32 * sub + 16 * u + 4 * hi;
            const s16x4 v00 = *(const LAS s16x4*)(VT + ql * 72 + kc), v01 = *(const LAS s16x4*)(VT + ql * 72 + kc + 8);
            const s16x4 v10 = *(const LAS s16x4*)(VT + (32 + ql) * 72 + kc), v11 = *(const LAS s16x4*)(VT + (32 + ql) * 72 + kc + 8);
            const bf16x8 va0 = {v00[0], v00[1], v00[2], v00[3], v01[0], v01[1], v01[2], v01[3]}, va1 = {v10[0], v10[1], v10[2], v10[3], v11[0], v11[1], v11[2], v11[3]};
            st.o0 = MFMA32(va0, pb, st.o0); st.o1 = MFMA32(va1, pb, st.o1);
        }
}
DI void nsa_ld(const bf16_t* hkv, int b, int g, int j, int kcol, u32x4& kr, u32x4& vr, int tid) {
    const int key = tid >> 3, d8 = (tid & 7) * 8; const bf16_t* src = hkv + (size_t)(b * SEQ + 64 * j + key) * 768 + g * 64 + d8;
    kr = *(const u32x4*)(src + kcol); vr = *(const u32x4*)(src + kcol + 128);
}
DI void nsa_st(LAS unsigned char* lds, int bufi, const u32x4& kr, const u32x4& vr, int tid) {
    const int key = tid >> 3, d8 = (tid & 7) * 8;
    *(LAS u32x4*)(lds + NA_KS + bufi * NA_TILE + (key * 72 + d8) * 2) = kr;
    LAS bf16_t* VT = (LAS bf16_t*)(lds + NA_VT + bufi * NA_TILE);
#pragma unroll
    for (int e = 0; e < 8; ++e) { const unsigned w = vr[e >> 1]; VT[(d8 + e) * 72 + key] = (unsigned short)((e & 1) ? (w >> 16) : (w & 0xffffu)); }
}
template <int MODE>
DI void nsa_branch(const Params& p, LAS unsigned char* lds, unsigned U, int b, int g, int kcol, const bf16x8 (&qf)[4], NsaState& st, int t, int hi, int wave, int lane, float c1, float slope2, unsigned myselm) {
    const bf16_t* hkv = (const bf16_t*)(p.ws + WS_HKV);
    const int tid = wave * 64 + lane;
    u32x4 kr, vr;
    unsigned rem = U;
    int j = __builtin_ctz(rem); rem &= rem - 1;
    nsa_ld(hkv, b, g, j, kcol, kr, vr, tid); nsa_st(lds, 0, kr, vr, tid);
    LDS_BARRIER();
    int it = 0;
    for (;;) {
        const bool more = rem != 0u; const int jn = more ? __builtin_ctz(rem) : j;
        rem &= rem - 1u;
        nsa_ld(hkv, b, g, jn, kcol, kr, vr, tid);
        const bool sel = (MODE == 1) ? true : (((myselm >> j) & 1u) != 0u);
        if (__any(sel)) nsa_tile<MODE>(lds, it & 1, qf, st, 64 * j, t, hi, lane, c1, slope2, sel);
        nsa_st(lds, (it + 1) & 1, kr, vr, tid);
        LDS_BARRIER();
        if (!more) break;
        j = jn; ++it;
    }
}
DI void nsa_unit(const Params& p, LAS unsigned char* lds, int unit, int wave, int lane) {
    const int tid = wave * 64 + lane;
    const int qb = 31 - (unit >> 4), bg = unit & 15, b = bg >> 1, g = bg & 1;
    const int t0 = qb * 64, ql = lane & 31, hi = lane >> 5, tl = 8 * wave + (ql >> 2), r = ql & 3, h = 4 * g + r, t = t0 + tl;
    const size_t rowg = (size_t)b * SEQ + t;
    const bf16_t* hq = (const bf16_t*)(p.ws + WS_HQ);
    const float* small = (const float*)(p.ws + WS_SMALL);
    bf16x8 qf[4];
#pragma unroll
    for (int kk = 0; kk < 4; ++kk) qf[kk] = *(const bf16x8*)(hq + rowg * 512 + h * 64 + 16 * kk + 8 * hi);
    const float slope2 = __builtin_amdgcn_exp2f(-(float)(h + 1)) * LOG2E, c1 = 0.125f * LOG2E;
    const float gc = sigmoidf_(small[rowg * 32 + h]), gs = sigmoidf_(small[rowg * 32 + 8 + h]), gw = sigmoidf_(small[rowg * 32 + 16 + h]);
    f32x16 oa0, oa1;
    LAS float* PS = (LAS float*)(lds + NA_PS);
    LAS unsigned* SELM = (LAS unsigned*)(lds + NA_SELM);
    LAS unsigned* UNI = (LAS unsigned*)(lds + NA_UNI);
    {
        const float* kc = (const float*)(p.ws + WS_KVC) + (size_t)((b * 2 + g) * 128) * 64;
        const float* vc = kc + (size_t)16 * 128 * 64;
        const int key = tid >> 2, d0 = (tid & 3) * 16, kb = key >> 6, kl = key & 63;
        f32x4 a[4], v[4];
#pragma unroll
        for (int e = 0; e < 4; ++e) { a[e] = *(const f32x4*)(kc + key * 64 + d0 + 4 * e); v[e] = *(const f32x4*)(vc + key * 64 + d0 + 4 * e); }
        *(LAS u32x4*)(lds + NA_KS + kb * NA_TILE + (kl * 72 + d0) * 2) = pack8(a[0], a[1]);
        *(LAS u32x4*)(lds + NA_KS + kb * NA_TILE + (kl * 72 + d0 + 8) * 2) = pack8(a[2], a[3]);
        LAS bf16_t* VT = (LAS bf16_t*)(lds + NA_VT + kb * NA_TILE);
#pragma unroll
        for (int e = 0; e < 16; ++e) VT[(d0 + e) * 72 + kl] = f2bf(v[e >> 2][e & 3]);
    }
    LDS_BARRIER();
    {
        int ncmp = 4 * qb + 3; if (ncmp > 127) ncmp = 127;
        const int nsub = (ncmp + 31) >> 5;
        float m = -1.0e30f, l = 0.f;
        float slc = slope2; asm volatile("" : "+v"(slc));
        const int tq16 = t - 64 * hi - 31;
        const float basec = -slc * (float)tq16;
#pragma unroll
        for (int sub = 0; sub < 4; ++sub) {
            if (sub < nsub) {
                f32x16 sc;
#pragma unroll
                for (int i = 0; i < 16; ++i) sc[i] = 0.f;
                const LAS bf16_t* KS = (const LAS bf16_t*)(lds + NA_KS + (sub >> 1) * NA_TILE) + ((sub & 1) * 32 + ql) * 72 + 8 * hi;
#pragma unroll
                for (int kk = 0; kk < 4; ++kk) sc = MFMA32(*(const LAS bf16x8*)(KS + 16 * kk), qf[kk], sc);
                float mx = -INFINITY;
#pragma unroll
                for (int i = 0; i < 16; ++i) { const int cn = 16 * (32 * sub + (i & 3) + 8 * (i >> 2));
                    const bool val = (tq16 >= cn) && !(sub == 3 && i == 15 && hi == 1);
                    sc[i] = val ? (sc[i] * c1 + (basec + slc * (float)cn)) : -INFINITY; mx = fmaxf(mx, sc[i]); }
                mx = fmaxf(mx, __shfl_xor(mx, 32));
                const float mnew = fmaxf(m, mx);
                float rs = 0.f;
#pragma unroll
                for (int i = 0; i < 16; ++i) rs += __builtin_amdgcn_exp2f(sc[i] - mnew);
                rs += __shfl_xor(rs, 32);
                l = l * __builtin_amdgcn_exp2f(m - mnew) + rs; m = mnew;
            }
            asm volatile("" ::: "memory");
        }
        const float inv = (l > 0.f) ? 1.f / l : 0.f;
        f32x16 o0, o1;
#pragma unroll
        for (int i = 0; i < 16; ++i) { o0[i] = 0.f; o1[i] = 0.f; }
#pragma unroll
        for (int sub = 0; sub < 4; ++sub) {
            f32x16 sc;
#pragma unroll
            for (int i = 0; i < 16; ++i) sc[i] = 0.f;
            if (sub < nsub) {
                const LAS bf16_t* KS = (const LAS bf16_t*)(lds + NA_KS + (sub >> 1) * NA_TILE) + ((sub & 1) * 32 + ql) * 72 + 8 * hi;
#pragma unroll
                for (int kk = 0; kk < 4; ++kk) sc = MFMA32(*(const LAS bf16x8*)(KS + 16 * kk), qf[kk], sc);
#pragma unroll
                for (int i = 0; i < 16; ++i) { const int cn = 16 * (32 * sub + (i & 3) + 8 * (i >> 2));
                    const bool val = (tq16 >= cn) && !(sub == 3 && i == 15 && hi == 1);
                    sc[i] = val ? __builtin_amdgcn_exp2f((sc[i] * c1 + (basec + slc * (float)cn)) - m) * inv : 0.f; }
            }
#pragma unroll
            for (int q = 0; q < 4; ++q) { float gsum = (sc[4 * q] + sc[4 * q + 1]) + (sc[4 * q + 2] + sc[4 * q + 3]), lst = sc[4 * q + 3];
                gsum += __shfl_xor(gsum, 1); gsum += __shfl_xor(gsum, 2); lst += __shfl_xor(lst, 1); lst += __shfl_xor(lst, 2);
                if (r == 0) *(LAS f32x2*)(PS + tl * 66 + 2 * (8 * sub + 2 * q + hi)) = (f32x2){gsum, lst}; }
            if (sub < nsub) {
                const LAS bf16_t* VT = (const LAS bf16_t*)(lds + NA_VT + (sub >> 1) * NA_TILE);
#pragma unroll
                for (int u = 0; u < 2; ++u) {
                    u32x4 pw; pw.x = pk2(sc[8 * u], sc[8 * u + 1]); pw.y = pk2(sc[8 * u + 2], sc[8 * u + 3]); pw.z = pk2(sc[8 * u + 4], sc[8 * u + 5]); pw.w = pk2(sc[8 * u + 6], sc[8 * u + 7]);
                    const bf16x8 pb = __builtin_bit_cast(bf16x8, pw);
                    const int kc2 = (sub & 1) * 32 + 16 * u + 4 * hi;
                    const s16x4 v00 = *(const LAS s16x4*)(VT + ql * 72 + kc2), v01 = *(const LAS s16x4*)(VT + ql * 72 + kc2 + 8);
                    const s16x4 v10 = *(const LAS s16x4*)(VT + (32 + ql) * 72 + kc2), v11 = *(const LAS s16x4*)(VT + (32 + ql) * 72 + kc2 + 8);
                    const bf16x8 va0 = {v00[0], v00[1], v00[2], v00[3], v01[0], v01[1], v01[2], v01[3]}, va1 = {v10[0], v10[1], v10[2], v10[3], v11[0], v11[1], v11[2], v11[3]};
                    o0 = MFMA32(va0, pb, o0); o1 = MFMA32(va1, pb, o1);
                }
            }
            asm volatile("" ::: "memory");
        }
        LAS float* oacc_ = (LAS float*)(lds + NA_OACC) + wave * 2048 + lane;
#pragma unroll
        for (int i = 0; i < 16; ++i) { oacc_[i * 64] = gc * o0[i]; oacc_[(16 + i) * 64] = gc * o1[i]; }
    }
    LDS_BARRIER();
    if (wave == 0) {
        const LAS float* pr = PS + lane * 66;
        float scv[32]; float lprev = 0.f;
#pragma unroll
        for (int j = 0; j < 32; ++j) { const f32x2 q2 = *(const LAS f32x2*)(pr + 2 * j); scv[j] = q2[0] + lprev; lprev = q2[1]; if ((j & 7) == 7) asm volatile("" ::: "memory"); }
#pragma unroll
        for (int j = 0; j < 32; ++j) { if (j == 0 || j == qb || j == qb - 1) scv[j] = 1.0e4f; else if (j > qb) scv[j] = -1.f; }
        unsigned msk = 0u;
#pragma unroll
        for (int k = 0; k < 8; ++k) { float best = -INFINITY; int bi = 0;
#pragma unroll
            for (int j = 0; j < 32; ++j) { const bool free_ = ((msk >> j) & 1u) == 0u; if (free_ && scv[j] > best) { best = scv[j]; bi = j; } }
            msk |= 1u << bi; }
        msk &= (2u << qb) - 1u;
        SELM[lane] = msk;
        unsigned un = msk;
#pragma unroll
        for (int o = 1; o < 64; o <<= 1) un |= __shfl_xor(un, o);
        if (lane == 0) UNI[0] = un;
    }
    LDS_BARRIER();
    const unsigned myselm = SELM[tl]; const unsigned U = UNI[0];
    {
        NsaState st; st.m = -1.0e30f; st.l = 0.f;
#pragma unroll
        for (int i = 0; i < 16; ++i) { st.o0[i] = 0.f; st.o1[i] = 0.f; }
        nsa_branch<0>(p, lds, U, b, g, 256, qf, st, t, hi, wave, lane, c1, slope2, myselm);
        const float f = (st.l > 0.f) ? gs / st.l : 0.f;
        LAS float* oacc_ = (LAS float*)(lds + NA_OACC) + wave * 2048 + lane;
#pragma unroll
        for (int i = 0; i < 16; ++i) { oacc_[i * 64] += f * st.o0[i]; oacc_[(16 + i) * 64] += f * st.o1[i]; }
    }
    {
        NsaState st; st.m = -1.0e30f; st.l = 0.f;
#pragma unroll
        for (int i = 0; i < 16; ++i) { st.o0[i] = 0.f; st.o1[i] = 0.f; }
        const int jlo = qb >= 8 ? qb - 8 : 0;
        const unsigned W = ((2u << qb) - 1u) & ~((1u << jlo) - 1u);
        nsa_branch<1>(p, lds, W, b, g, 512, qf, st, t, hi, wave, lane, c1, slope2, 0u);
        const float f = (st.l > 0.f) ? gw / st.l : 0.f;
        const LAS float* oacc_ = (const LAS float*)(lds + NA_OACC) + wave * 2048 + lane;
#pragma unroll
        for (int i = 0; i < 16; ++i) { oa0[i] = oacc_[i * 64] + f * st.o0[i]; oa1[i] = oacc_[(16 + i) * 64] + f * st.o1[i]; }
    }
    bf16_t* no = (bf16_t*)(p.ws + WS_R32) + rowg * 512 + h * 64;
#pragma unroll
    for (int q4 = 0; q4 < 4; ++q4) {
        u32x2 w0; w0.x = pk2(oa0[4 * q4], oa0[4 * q4 + 1]); w0.y = pk2(oa0[4 * q4 + 2], oa0[4 * q4 + 3]);
        u32x2 w1; w1.x = pk2(oa1[4 * q4], oa1[4 * q4 + 1]); w1.y = pk2(oa1[4 * q4 + 2], oa1[4 * q4 + 3]);
        *(u32x2*)(no + 8 * q4 + 4 * hi) = w0; *(u32x2*)(no + 32 + 8 * q4 + 4 * hi) = w1;
    }
    LDS_BARRIER();
}

DI void ln_rows(const float* zin, float* xout, bf16_t* xb, const float* gam, const float* bet, int gw, int NGW, int lane, float delta = 0.f) {
    f32x4 gv[4], bv[4];
#pragma unroll
    for (int j = 0; j < 4; ++j) { gv[j] = *(const f32x4*)(gam + lane * 4 + 256 * j); bv[j] = *(const f32x4*)(bet + lane * 4 + 256 * j); }
    for (int m = gw; m < M; m += NGW) {
        const float* zr = zin + (size_t)m * DM + lane * 4;
        f32x4 v[4]; float s = 0.f;
#pragma unroll
        for (int j = 0; j < 4; ++j) { v[j] = *(const f32x4*)(zr + 256 * j); s += (v[j][0] + v[j][1]) + (v[j][2] + v[j][3]); }
        const float mean = wave_sum(s) * (1.f / DM); float s2 = 0.f;
#pragma unroll
        for (int j = 0; j < 4; ++j) { v[j] = v[j] - mean; s2 += (v[j][0] * v[j][0] + v[j][1] * v[j][1]) + (v[j][2] * v[j][2] + v[j][3] * v[j][3]); }
        const float rstd = rsqrtf(wave_sum(s2) * (1.f / DM) + 1e-5f);
#pragma unroll
        for (int j = 0; j < 4; ++j) { f32x4 o = v[j] * rstd * gv[j] + bv[j]; o[0] += delta; o[1] -= delta; o[2] += delta; o[3] -= delta;
            *(f32x4*)(xout + (size_t)m * DM + lane * 4 + 256 * j) = o;
            if (xb) { u32x2 w; w.x = pk2(o[0], o[1]); w.y = pk2(o[2], o[3]); *(u32x2*)(xb + (size_t)m * DM + lane * 4 + 256 * j) = w; } }
    }
}

constexpr int NPHASE = 11;
__global__ void __launch_bounds__(512, 2) fwd_kernel(Params p) {
    extern __shared__ __attribute__((aligned(16))) unsigned char lds_raw[];
    LAS unsigned char* lds = (LAS unsigned char*)lds_raw;
    cg::grid_group grid = cg::this_grid();
    const int wave = __builtin_amdgcn_readfirstlane((int)threadIdx.x >> 6), lane = lane_id(), tid = wave * 64 + lane;
    const int G = gridDim.x, bx = blockIdx.x;
    const int lo = p.ph_lo, hi = p.ph_hi;
    unsigned* ctl = (unsigned*)(p.ws + WS_CTL);
#ifndef PHMASK
#define PHMASK 0xffff
#endif
#define IN(k) (((PHMASK >> (k)) & 1) && lo <= (k) && (k) < hi)
#define SEAM(k) do { if (IN(k) && IN((k) + 1)) grid.sync(); STAMP((k) + 1); } while (0)
#ifndef TSA
#define TSA -1
#define TSB -1
#endif
#define STAMP(i) do { if (TSA >= 0 && bx == 0 && tid == 0) ((unsigned long long*)(p.ws + WS_CTL + 1024))[i] = __builtin_amdgcn_s_memrealtime(); } while (0)
    STAMP(0);
    bf16_t* const r32 = (bf16_t*)(p.ws + WS_R32);
    if (IN(0)) { p0_prologue(p, lds, wave, lane); }
    SEAM(0);
    if (IN(1)) {
        pg8::Gemm g{r32, (const bf16_t*)(p.ws + WS_WIN), M, NIN, DM, DM, 0, 256}; pg8::StaticOrder S; S.init(M, NIN, G, bx);
        EpiH E{(bf16_t*)(p.ws + WS_HQ), (bf16_t*)(p.ws + WS_HKV), (bf16_t*)(p.ws + WS_HG), (bf16_t*)(p.ws + WS_HGG), (bf16_t*)(p.ws + WS_HM), (float*)(p.ws + WS_SMALL)};
        pg8::gemm_phase<EpiH>(lds, g, S, E, wave);
    }
    SEAM(1);
    if (IN(2)) {
        for (int task = bx; task < 256; task += G) cmp_task(p, lds, task, wave, lane);
        for (int task = bx; task < 1024; task += G) gdn_prep_task(p, lds, task, wave, lane);
    }
    SEAM(2);
    if (IN(3)) {
        if (TSA >= 20 && bx == 0 && tid == 0) ((unsigned long long*)(p.ws + WS_CTL + 1024))[20] = __builtin_amdgcn_s_memrealtime();
        if (bx < 32) gdn_scan(p, lds, bx, wave, lane);
        if (TSA >= 20 && bx == 0 && tid == 0) ((unsigned long long*)(p.ws + WS_CTL + 1024))[21] = __builtin_amdgcn_s_memrealtime();
        int nun_ = 0;
        LAS unsigned* qslot = (LAS unsigned*)(lds + NA_Q);
        for (;;) {
            __syncthreads();
            if (tid == 0) qslot[0] = atomicAdd(ctl + p.rep, 1u);
            __syncthreads();
            const unsigned unit = qslot[0];
            if (unit >= 512u) break;
            if (TSA >= 20 && bx == 40 && tid == 0 && nun_ < 2) ((unsigned long long*)(p.ws + WS_CTL + 1024))[22 + nun_] = __builtin_amdgcn_s_memrealtime();
            nsa_unit(p, lds, (int)unit, wave, lane);
            ++nun_;
        }
    }
    SEAM(3);
    if (IN(4)) {
        bf16_t* mix = (bf16_t*)(p.ws + WS_MIX);
        { pg8::Gemm g{r32, (const bf16_t*)(p.ws + WS_WNSA), M, DM, 512, 512, 0, 256}; pg8::StaticOrder S; S.init(M, DM, G, bx);
          EpiGate<0> E{(const bf16_t*)(p.ws + WS_HM), mix}; pg8::gemm_phase<EpiGate<0>>(lds, g, S, E, wave); }
        { pg8::Gemm g{r32 + (size_t)M * 512, (const bf16_t*)(p.ws + WS_WGDN), M, DM, 512, 512, 0, 256}; pg8::StaticOrder S; S.init(M, DM, G, bx);
          EpiGate<1> E{(const bf16_t*)(p.ws + WS_HM), mix}; pg8::gemm_phase<EpiGate<1>>(lds, g, S, E, wave); }
    }
    SEAM(4);
    if (IN(5)) {
        pg8::Gemm g{(const bf16_t*)(p.ws + WS_MIX), (const bf16_t*)(p.ws + WS_WO), M, DM, DM, DM, 0, 256}; pg8::StaticOrder S; S.init(M, DM, G, bx);
        EpiZ E{p.x, p.out}; pg8::gemm_phase<EpiZ>(lds, g, S, E, wave);
    }
    SEAM(5);
    if (IN(6)) { ln_rows(p.out, p.out, r32, p.ln1g, p.ln1b, bx * 8 + wave, G * 8, lane); }
    SEAM(6);
    if (IN(7)) {
        pg8::Gemm g{r32, (const bf16_t*)(p.ws + WS_WUP), M, FF2, DM, DM, -2, 254}; pg8::StaticOrder S; S.init2(65, 22, G, bx);
        EpiUpAct E{(bf16_t*)(p.ws + WS_ACT), p.ffn_conv, (LAS float*)(lds + 131072)}; pg8::gemm_phase<EpiUpAct>(lds, g, S, E, wave);
    }
    SEAM(7);
    if (IN(9)) {
        pg8::Gemm g{(const bf16_t*)(p.ws + WS_ACT), (const bf16_t*)(p.ws + WS_WDN), M, DM, FF, FF, 0, 256}; pg8::StaticOrder S; S.init(M, DM, G, bx);
        EpiZ E{p.out, p.out}; pg8::gemm_phase<EpiZ>(lds, g, S, E, wave);
    }
    SEAM(9);
    if (IN(10)) { float delta = 0.f;
        if (TSA >= 0) grid.sync();
        if (TSA >= 0) { const unsigned long long* ts = (const unsigned long long*)(p.ws + WS_CTL + 1024); delta = (float)(long long)(ts[TSB < 0 ? 0 : TSB] - ts[TSA < 0 ? 0 : TSA]) * 0.5e-7f; }
        ln_rows(p.out, p.out, nullptr, p.ln2g, p.ln2b, bx * 8 + wave, G * 8, lane, delta); }
#undef IN
#undef SEAM
}

#define REPEAT 0
#ifndef N_LAUNCH_MODE
#define N_LAUNCH_MODE 1
#endif
extern "C" void kernel_launch(void* const* d_in, const int* in_sizes, int n_in, void* d_out, int out_size, void* d_ws, size_t ws_size, hipStream_t stream) {
    static int grid = 0;
    if (grid == 0) {
        if (n_in != 19 || out_size != M * DM || ws_size < WS_END) { fprintf(stderr, "kernel_launch: unexpected shapes (n_in %d out %d ws %zu)\n", n_in, out_size, ws_size); grid = -1; return; }
        int dev = 0, cus = 0, per_cu = 0;
        (void)hipGetDevice(&dev);
        (void)hipDeviceGetAttribute(&cus, hipDeviceAttributeMultiprocessorCount, dev);
        (void)hipFuncSetAttribute((const void*)fwd_kernel, hipFuncAttributeMaxDynamicSharedMemorySize, LDS_BYTES);
        (void)hipOccupancyMaxActiveBlocksPerMultiprocessor(&per_cu, (const void*)fwd_kernel, 512, LDS_BYTES);
        if (per_cu < 1) per_cu = 1;
        grid = cus * per_cu;
        fprintf(stderr, "kernel_launch: grid %d (cus %d x %d)\n", grid, cus, per_cu);
    }
    if (grid < 0) return;
    (void)hipMemsetAsync((char*)d_ws + WS_CTL, 0, 4096, stream);
    Params p{};
    const float** pp = (const float**)&p;
    for (int i = 0; i < 19; ++i) pp[i] = (const float*)d_in[i];
    p.out = (float*)d_out; p.ws = (unsigned char*)d_ws;
#if N_LAUNCH_MODE == 1
    p.ph_lo = 0; p.ph_hi = NPHASE;
    void* args[] = {&p};
    hipError_t e = hipLaunchCooperativeKernel((const void*)fwd_kernel, dim3(grid), dim3(512), args, LDS_BYTES, stream);
    if (e != hipSuccess) fprintf(stderr, "cooperative launch failed: %s (grid %d)\n", hipGetErrorString(e), grid);
#else
    for (int ph = 0; ph < NPHASE; ++ph) { p.ph_lo = ph; p.ph_hi = ph + 1; p.rep = 0; hipLaunchKernelGGL(fwd_kernel, dim3(grid), dim3(512), LDS_BYTES, stream, p);
        if ((REPEAT >> ph) & 1) { p.rep = 1; hipLaunchKernelGGL(fwd_kernel, dim3(grid), dim3(512), LDS_BYTES, stream, p); } }
#endif
}
```
